# Optimizing an MI355X kernel written in HIP

```python
import jax, jax.numpy as jnp
from jax import lax
import numpy as np

D_MODEL = 2048
BATCH = 8
SEQ = 2048
DEPTH = 1

HEAD_DIM = 64
N_Q_HEADS = D_MODEL // HEAD_DIM
N_KV_HEADS = 4
GQA_GROUP = N_Q_HEADS // N_KV_HEADS
WINDOW = 128

GLA_HEADS = 4
GLA_DK = (D_MODEL // 2) // GLA_HEADS
GLA_DV = D_MODEL // GLA_HEADS
GLA_GATE_RANK = 16
GLA_GATE_NORMALIZER = 16.0
GLA_CHUNK = 64

FFN_HIDDEN = ((8 * D_MODEL // 3 + 255) // 256) * 256

RMS_EPS = 1e-6
MASK_VALUE = -1e30

IN_WIDTHS = (
    N_Q_HEADS * HEAD_DIM,
    N_KV_HEADS * HEAD_DIM,
    N_KV_HEADS * HEAD_DIM,
    GLA_HEADS * GLA_DK,
    GLA_HEADS * GLA_DK,
    GLA_HEADS * GLA_DV,
    GLA_GATE_RANK,
    GLA_HEADS * GLA_DV,
    D_MODEL,
    D_MODEL,
)
D_IN = sum(IN_WIDTHS)

kernel_name = "hybrid_swa_sink_gla_swiglu_block"


def _rmsnorm(x, w):
    xf = x.astype(jnp.float32)
    y = xf * lax.rsqrt(jnp.mean(xf * xf, axis=-1, keepdims=True) + RMS_EPS)
    return (y * w.astype(jnp.float32)).astype(x.dtype)


def _split_offsets():
    offs, acc = [], 0
    for w in IN_WIDTHS[:-1]:
        acc += w
        offs.append(acc)
    return offs


def _swa_sink_attention(q, k, v, sinks):
    B, T = q.shape[0], q.shape[1]
    nb = T // WINDOW
    qb = q.reshape(B, nb, WINDOW, N_KV_HEADS, GQA_GROUP, HEAD_DIM)
    kb = k.reshape(B, nb, WINDOW, N_KV_HEADS, HEAD_DIM)
    vb = v.reshape(B, nb, WINDOW, N_KV_HEADS, HEAD_DIM)
    k_prev = jnp.concatenate([jnp.zeros_like(kb[:, :1]), kb[:, :-1]], axis=1)
    v_prev = jnp.concatenate([jnp.zeros_like(vb[:, :1]), vb[:, :-1]], axis=1)
    kk = jnp.concatenate([k_prev, kb], axis=2)
    vv = jnp.concatenate([v_prev, vb], axis=2)
    s = jnp.einsum('bnqhgd,bnkhd->bhgnqk', qb, kk).astype(jnp.float32) * (HEAD_DIM ** -0.5)
    qi = jnp.arange(WINDOW)[:, None]
    ki = jnp.arange(2 * WINDOW)[None, :]
    rel = qi + WINDOW - ki
    band = (rel >= 0) & (rel < WINDOW)
    blk = jnp.arange(nb)[:, None, None]
    mask = band[None] & ((blk > 0) | (ki[None] >= WINDOW))
    s = jnp.where(mask, s, MASK_VALUE)
    sink = sinks.astype(jnp.float32).reshape(N_KV_HEADS, GQA_GROUP)[None, :, :, None, None, None]
    sink = jnp.broadcast_to(sink, s.shape[:-1] + (1,))
    p = jax.nn.softmax(jnp.concatenate([s, sink], axis=-1), axis=-1)[..., :-1]
    o = jnp.einsum('bhgnqk,bnkhd->bnqhgd', p.astype(vv.dtype), vv)
    return o.reshape(B, T, N_Q_HEADS * HEAD_DIM)


def _gla(q, k, v, log_a):
    B, T = q.shape[0], q.shape[1]
    nc = T // GLA_CHUNK

    def chunk(t, d):
        return t.astype(jnp.float32).reshape(B, nc, GLA_CHUNK, GLA_HEADS, d).transpose(0, 3, 1, 2, 4)

    qc = chunk(q, GLA_DK) * (GLA_DK ** -0.5)
    kc = chunk(k, GLA_DK)
    vc = chunk(v, GLA_DV)
    g = jnp.cumsum(chunk(log_a, GLA_DK), axis=3)
    g_last = g[..., -1:, :]
    q_dec = qc * jnp.exp(g)
    k_inv = kc * jnp.exp(-g)
    k_to_end = kc * jnp.exp(g_last - g)
    causal = jnp.tril(jnp.ones((GLA_CHUNK, GLA_CHUNK), dtype=bool))
    att = jnp.where(causal, jnp.einsum('bhnid,bhnjd->bhnij', q_dec, k_inv), 0.0)
    o_intra = jnp.einsum('bhnij,bhnjv->bhniv', att, vc)
    upd = jnp.einsum('bhnjd,bhnjv->bhndv', k_to_end, vc)
    decay = jnp.exp(g_last[..., 0, :])

    def step(state, inp):
        d_c, u_c = inp
        return d_c[..., None] * state + u_c, state

    s0 = jnp.zeros((B, GLA_HEADS, GLA_DK, GLA_DV), jnp.float32)
    _, s_prev = lax.scan(step, s0, (jnp.moveaxis(decay, 2, 0), jnp.moveaxis(upd, 2, 0)))
    s_prev = jnp.moveaxis(s_prev, 0, 2)
    o_inter = jnp.einsum('bhnid,bhndv->bhniv', q_dec, s_prev)
    o = o_intra + o_inter
    return o.transpose(0, 2, 3, 1, 4).reshape(B, T, GLA_HEADS, GLA_DV)


def setup_inputs(seed: int = 0) -> dict:
    key = jax.random.key(seed)
    ks = jax.random.split(key, 14)
    f32 = jnp.float32

    def normal(k, shape, scale):
        return jax.random.normal(k, shape, f32) * scale

    return {
        "x": jax.random.normal(ks[0], (BATCH, SEQ, D_MODEL), f32),
        "norm1_w": 1.0 + normal(ks[1], (DEPTH, D_MODEL), 0.02),
        "w_in": normal(ks[2], (DEPTH, D_MODEL, D_IN), D_MODEL ** -0.5),
        "gla_gate_w2": normal(ks[3], (DEPTH, GLA_GATE_RANK, GLA_HEADS * GLA_DK), GLA_GATE_RANK ** -0.5),
        "gla_gate_b": normal(ks[4], (DEPTH, GLA_HEADS * GLA_DK), 0.02),
        "attn_sinks": normal(ks[5], (DEPTH, N_Q_HEADS), 0.5),
        "gla_norm_w": 1.0 + normal(ks[6], (DEPTH, GLA_DV), 0.02),
        "w_out": normal(ks[7], (DEPTH, D_MODEL, D_MODEL), D_MODEL ** -0.5),
        "norm2_w": 1.0 + normal(ks[8], (DEPTH, D_MODEL), 0.02),
        "w_ffn_gate": normal(ks[9], (DEPTH, D_MODEL, FFN_HIDDEN), D_MODEL ** -0.5),
        "w_ffn_up": normal(ks[10], (DEPTH, D_MODEL, FFN_HIDDEN), D_MODEL ** -0.5),
        "w_ffn_down": normal(ks[11], (DEPTH, FFN_HIDDEN, D_MODEL), FFN_HIDDEN ** -0.5),
        "final_norm_w": 1.0 + normal(ks[12], (D_MODEL,), 0.02),
    }


def reference(x, norm1_w, w_in, gla_gate_w2, gla_gate_b, attn_sinks, gla_norm_w, w_out,
              norm2_w, w_ffn_gate, w_ffn_up, w_ffn_down, final_norm_w):
    B, T, _ = x.shape
    offs = _split_offsets()
    h = x
    for l in range(DEPTH):
        u = _rmsnorm(h, norm1_w[l])
        proj = u @ w_in[l]
        aq, ak, av, gq, gk, gv, g_lr, g_r, gate_a, gate_b = jnp.split(proj, offs, axis=-1)

        attn_o = _swa_sink_attention(aq, ak, av, attn_sinks[l])

        gate_logit = (g_lr @ gla_gate_w2[l] + gla_gate_b[l]).astype(jnp.float32)
        log_a = jax.nn.log_sigmoid(gate_logit) / GLA_GATE_NORMALIZER
        gla_o = _gla(gq.reshape(B, T, GLA_HEADS, GLA_DK),
                     gk.reshape(B, T, GLA_HEADS, GLA_DK),
                     gv.reshape(B, T, GLA_HEADS, GLA_DV),
                     log_a.reshape(B, T, GLA_HEADS, GLA_DK))
        gla_o = _rmsnorm(gla_o, gla_norm_w[l]).astype(x.dtype)
        gla_o = gla_o.reshape(B, T, GLA_HEADS * GLA_DV) * jax.nn.silu(g_r)

        merged = jax.nn.sigmoid(gate_a) * attn_o + jax.nn.sigmoid(gate_b) * gla_o
        h = h + merged @ w_out[l]

        v2 = _rmsnorm(h, norm2_w[l])
        ff = jax.nn.silu(v2 @ w_ffn_gate[l]) * (v2 @ w_ffn_up[l])
        h = h + ff @ w_ffn_down[l]
    return _rmsnorm(h, final_norm_w)
```

```cpp
#include <hip/hip_runtime.h>
#include <cstdio>
#include <cstdint>

#ifndef MK_N_LAUNCHES
#define MK_N_LAUNCHES 1
#endif

namespace pg8 {
#define PG8_LAS __attribute__((address_space(3)))
typedef unsigned short bf16_t;
typedef short bf16x8 __attribute__((ext_vector_type(8)));
typedef float f32x4 __attribute__((ext_vector_type(4)));
typedef unsigned u32x4 __attribute__((ext_vector_type(4)));
constexpr int BM = 256, BK = 64, HALF = 128, HTB = HALF * BK * 2  , STAGE_BYTES = 8 * HTB, NXCD = 8, WGM = 8;

__host__ __device__ __forceinline__ int lds_byte(int r, int c) { const int st = (r >> 4) * 2 + (c >> 5), rr = r & 15, cc = c & 31, ob = rr * 64 + cc * 2; return st * 1024 + (ob ^ (((ob >> 9) & 1) << 5)); }
__host__ __device__ __forceinline__ void stage_rc(int b, int& R, int& C) { const int st = b / 1024, sb = b % 1024, swz = sb ^ (((sb >> 9) & 1) << 5); R = (st >> 1) * 16 + swz / 64; C = (st & 1) * 32 + (swz % 64) / 2; }
__host__ __device__ __forceinline__ int perm32(int rho) { const int n = rho >> 4, i = rho & 15; return 8 * (i >> 2) + 4 * n + (i & 3); }

struct Unit { int pm, pn; };
struct Gemm { const bf16_t* A; const bf16_t* Bt; int M, N, K; };

struct StaticOrder {
    int nM, nN, nwg, G, c;
    __host__ __device__ void init(int M, int N, int G_, int c_) { nM = M / BM; nN = N / BM; nwg = nM * nN; G = G_; c = c_; }
    __host__ __device__ bool next(int i, Unit& u) const {
        const long L = (long)i * G + c; if (L >= nwg) return false;
        int wgid = (int)L; { const int q = nwg / NXCD, r = nwg % NXCD, xcd = wgid % NXCD, off = wgid / NXCD; wgid = (xcd < r ? xcd * (q + 1) : r * (q + 1) + (xcd - r) * q) + off; }
        const int nig = WGM * nN, gid = wgid / nig, fm = gid * WGM, gsz = (nM - fm) < WGM ? (nM - fm) : WGM;
        u.pm = fm + ((wgid % nig) % gsz); u.pn = (wgid % nig) / gsz; return true;
    }
    __device__ __forceinline__ void a_ready(const Unit&) const {}
    __device__ __forceinline__ void done(const Unit&) const {}
};

__device__ __forceinline__ unsigned cvt_pk_bf16(float lo, float hi) { unsigned r; asm volatile("v_cvt_pk_bf16_f32 %0, %1, %2" : "=v"(r) : "v"(lo), "v"(hi)); return r; }
__device__ __forceinline__ float sum4(const f32x4 v) { return (v[0] + v[1]) + (v[2] + v[3]); }
__device__ __forceinline__ float sq4(const f32x4 v) { return (v[0] * v[0] + v[1] * v[1]) + (v[2] * v[2] + v[3] * v[3]); }
constexpr float RMS_EPS = 1e-6f;

struct EpiProj {
    static constexpr bool PERM = true, AFTER_DRAIN = false;
    bf16_t* O; int ldc; const float* rstd; float* glr; int glr_tile;
    __device__ __forceinline__ void operator()(const f32x4 (&acc)[2][2][4][2], const Unit& u, int wr, int wc, int fr, int fq) const {
        const int row0 = u.pm * BM + wr * 64 + fr;
        float rs[2][4];
#pragma unroll
        for (int ai = 0; ai < 2; ++ai)
#pragma unroll
            for (int m = 0; m < 4; ++m) rs[ai][m] = rstd[row0 + ai * HALF + m * 16];
        if (u.pn == glr_tile) {
            if (wc == 0 && fq < 2) {
#pragma unroll
                for (int ai = 0; ai < 2; ++ai)
#pragma unroll
                    for (int m = 0; m < 4; ++m) { float* p = glr + (size_t)(row0 + ai * HALF + m * 16) * 16 + 8 * fq;
                        *(f32x4*)p = acc[ai][0][m][0] * rs[ai][m]; *(f32x4*)(p + 4) = acc[ai][0][m][1] * rs[ai][m]; }
            }
            return;
        }
        const int col0 = u.pn * BM + wc * 32 + 8 * fq;
#pragma unroll
        for (int ai = 0; ai < 2; ++ai)
#pragma unroll
            for (int m = 0; m < 4; ++m) { bf16_t* rowp = O + (size_t)(row0 + ai * HALF + m * 16) * ldc + col0; const float s = rs[ai][m];
#pragma unroll
                for (int bj = 0; bj < 2; ++bj) { const f32x4 v0 = acc[ai][bj][m][0] * s, v1 = acc[ai][bj][m][1] * s;
                    u32x4 w; w.x = cvt_pk_bf16(v0[0], v0[1]); w.y = cvt_pk_bf16(v0[2], v0[3]); w.z = cvt_pk_bf16(v1[0], v1[1]); w.w = cvt_pk_bf16(v1[2], v1[3]);
                    *(u32x4*)(rowp + bj * HALF) = w; } }
    }
};
struct EpiRes {
    static constexpr bool PERM = true, AFTER_DRAIN = false;
    const float* base; float* out; bf16_t* outb; int ldc; float* ssq;
    __device__ __forceinline__ void operator()(const f32x4 (&acc)[2][2][4][2], const Unit& u, int wr, int wc, int fr, int fq) const {
        const int row0 = u.pm * BM + wr * 64 + fr, col0 = u.pn * BM + wc * 32 + 8 * fq;
#pragma unroll
        for (int ai = 0; ai < 2; ++ai)
#pragma unroll
            for (int m = 0; m < 4; ++m) { const int row = row0 + ai * HALF + m * 16; const size_t off = (size_t)row * ldc + col0; float s = 0.f;
#pragma unroll
                for (int bj = 0; bj < 2; ++bj) { const f32x4 b0 = *(const f32x4*)(base + off + bj * HALF), b1 = *(const f32x4*)(base + off + bj * HALF + 4);
                    const f32x4 v0 = acc[ai][bj][m][0] + b0, v1 = acc[ai][bj][m][1] + b1;
                    *(f32x4*)(out + off + bj * HALF) = v0; *(f32x4*)(out + off + bj * HALF + 4) = v1;
                    if (outb) { u32x4 w; w.x = cvt_pk_bf16(v0[0], v0[1]); w.y = cvt_pk_bf16(v0[2], v0[3]); w.z = cvt_pk_bf16(v1[0], v1[1]); w.w = cvt_pk_bf16(v1[2], v1[3]); *(u32x4*)(outb + off + bj * HALF) = w; }
                    s += sq4(v0) + sq4(v1); }
                s += __shfl_xor(s, 16); s += __shfl_xor(s, 32);
                if (fq == 0) ssq[(size_t)row * 32 + u.pn * 4 + wc] = s; }
    }
};
struct EpiSwiGLU {
    static constexpr bool PERM = true, AFTER_DRAIN = false;
    bf16_t* ff; int ldc; const float* ssq; float inv_n;
    __device__ __forceinline__ void operator()(const f32x4 (&acc)[2][2][4][2], const Unit& u, int wr, int wc, int fr, int fq) const {
        const int row0 = u.pm * BM + wr * 64 + fr, col0 = u.pn * HALF + wc * 32 + 8 * fq;
#pragma unroll
        for (int ai = 0; ai < 2; ++ai)
#pragma unroll
            for (int m = 0; m < 4; ++m) { const int row = row0 + ai * HALF + m * 16;
                const f32x4* sp = (const f32x4*)(ssq + (size_t)row * 32 + fq * 8); float s = sum4(sp[0]) + sum4(sp[1]);
                s += __shfl_xor(s, 16); s += __shfl_xor(s, 32);
                const float rs = 1.0f / sqrtf(s * inv_n + RMS_EPS);
                float f[8];
#pragma unroll
                for (int n = 0; n < 2; ++n)
#pragma unroll
                    for (int i = 0; i < 4; ++i) { const float g = acc[ai][0][m][n][i] * rs, up = acc[ai][1][m][n][i] * rs;
                        f[4 * n + i] = g * __builtin_amdgcn_rcpf(1.0f + __builtin_amdgcn_exp2f(-1.4426950408889634f * g)) * up; }
                u32x4 w; w.x = cvt_pk_bf16(f[0], f[1]); w.y = cvt_pk_bf16(f[2], f[3]); w.z = cvt_pk_bf16(f[4], f[5]); w.w = cvt_pk_bf16(f[6], f[7]);
                *(u32x4*)(ff + (size_t)row * ldc + col0) = w; }
    }
};

template <class Epi, class Sched, bool ALIGN_EPI = false, bool SP2 = false>
__device__ __forceinline__ void gemm_phase(PG8_LAS unsigned char* lds, const Gemm g, const Sched& S, const Epi& E) {
    const int tid = threadIdx.x, wid = __builtin_amdgcn_readfirstlane(tid >> 6), lane = tid & 63, wr = wid >> 2, wc = wid & 3, fr = lane & 15, fq = lane >> 4;
    const int K = g.K, nt = K / BK;
    unsigned voffA[2], voffB[2];
#pragma unroll
    for (int i = 0; i < 2; ++i) { int R, C; stage_rc(tid * 16 + i * 8192, R, C); const int Rb = Epi::PERM ? ((R & ~31) + perm32(R & 31)) : R;
        voffA[i] = (unsigned)(R * K + C) * 2u; voffB[i] = (unsigned)(Rb * K + C) * 2u; }
    const size_t kstep = (size_t)(BK * 2);
    const size_t hstep = (size_t)HALF * K * 2;
    const size_t tstep = 2 * hstep;
    const unsigned ldsw = (unsigned)wid * 1024u;
    const int aoff = lds_byte(wr * 64 + fr, fq * 8), boff = lds_byte(wc * 32 + fr, fq * 8);
#define PG8_SA(b, h) (((b) * 2 + (h)) * HTB)
#define PG8_SB(b, h) ((4 + (b) * 2 + (h)) * HTB)
#define PG8_STAGE(bufoff, gbase, voff) do { _Pragma("unroll") for (int _i = 0; _i < 2; ++_i) \
        __builtin_amdgcn_global_load_lds((const unsigned*)((const char*)(gbase) + (voff)[_i]), (PG8_LAS unsigned*)(lds + (bufoff) + ldsw + _i * 8192), 16, 0, 0); } while (0)
#define PG8_LDA(dst, b, h) do { _Pragma("unroll") for (int m = 0; m < 4; ++m) _Pragma("unroll") for (int k = 0; k < 2; ++k) dst[m][k] = *(const PG8_LAS bf16x8*)(lds + PG8_SA(b, h) + aoff + m * 2048 + k * 1024); } while (0)
#define PG8_LDB(dst, b, h) do { _Pragma("unroll") for (int n = 0; n < 2; ++n) _Pragma("unroll") for (int k = 0; k < 2; ++k) dst[n][k] = *(const PG8_LAS bf16x8*)(lds + PG8_SB(b, h) + boff + n * 2048 + k * 1024); } while (0)
#define PG8_MMA(ai, bj, At, Bt) do { __builtin_amdgcn_s_setprio(1); _Pragma("unroll") for (int m = 0; m < 4; ++m) _Pragma("unroll") for (int n = 0; n < 2; ++n) _Pragma("unroll") for (int k = 0; k < 2; ++k) \
        acc[ai][bj][m][n] = __builtin_amdgcn_mfma_f32_16x16x32_bf16(Bt[n][k], At[m][k], acc[ai][bj][m][n], 0, 0, 0); __builtin_amdgcn_s_setprio(0); } while (0)
#define PG8_WAIT_V(n) asm volatile("s_waitcnt vmcnt(" #n ")" ::: "memory")
#define PG8_WAIT_L(n) asm volatile("s_waitcnt lgkmcnt(" #n ")" ::: "memory")
#define PG8_BAR __builtin_amdgcn_s_barrier()
#define PG8_SCHED __builtin_amdgcn_sched_barrier(0)
    Unit cur, nxt; int ui = 0;
    if (!S.next(0, cur)) return;
    f32x4 acc[2][2][4][2];
#pragma unroll
    for (int a = 0; a < 2; ++a)
#pragma unroll
        for (int b = 0; b < 2; ++b)
#pragma unroll
            for (int m = 0; m < 4; ++m)
#pragma unroll
                for (int n = 0; n < 2; ++n) acc[a][b][m][n] = (f32x4){0.f, 0.f, 0.f, 0.f};
    bf16x8 At[4][2], B0[2][2], B1[2][2];
    const char* cA = (const char*)g.A + (size_t)cur.pm * tstep; const char* cB = (const char*)g.Bt + (size_t)cur.pn * tstep;
    S.a_ready(cur);
    if constexpr (SP2) {
        PG8_STAGE(PG8_SB(0, 0), cB, voffB); PG8_STAGE(PG8_SB(0, 1), cB + hstep, voffB); PG8_STAGE(PG8_SA(0, 0), cA, voffA); PG8_STAGE(PG8_SA(0, 1), cA + hstep, voffA);
        if (wr == 1) PG8_BAR;
        PG8_WAIT_V(2); PG8_BAR;
        PG8_STAGE(PG8_SB(1, 0), cB + kstep, voffB); PG8_STAGE(PG8_SA(1, 0), cA + kstep, voffA); PG8_STAGE(PG8_SB(1, 1), cB + hstep + kstep, voffB);
        PG8_WAIT_V(6); PG8_BAR;
    } else {
        PG8_STAGE(PG8_SB(0, 0), cB, voffB); PG8_STAGE(PG8_SA(0, 0), cA, voffA); PG8_STAGE(PG8_SB(0, 1), cB + hstep, voffB); PG8_STAGE(PG8_SA(0, 1), cA + hstep, voffA);
        if (wr == 1) PG8_BAR;
        PG8_WAIT_V(4); PG8_BAR;
        PG8_STAGE(PG8_SB(1, 0), cB + kstep, voffB); PG8_STAGE(PG8_SA(1, 0), cA + kstep, voffA); PG8_STAGE(PG8_SB(1, 1), cB + hstep + kstep, voffB);
        PG8_WAIT_V(6); PG8_BAR;
    }
    for (;;) {
        const bool has_next = S.next(ui + 1, nxt);
        const char* nA = has_next ? (const char*)g.A + (size_t)nxt.pm * tstep : cA; const char* nB = has_next ? (const char*)g.Bt + (size_t)nxt.pn * tstep : cB;
        for (int t = 0; t < nt; t += 2) {
            const bool last = (t == nt - 2);
            const char* a1 = cA + (size_t)(t + 1) * kstep;
            const char* a2 = last ? nA : cA + (size_t)(t + 2) * kstep; const char* b2 = last ? nB : cB + (size_t)(t + 2) * kstep;
            const char* a3 = a2 + kstep; const char* b3 = b2 + kstep;
            if (last && has_next) S.a_ready(nxt);
            if constexpr (SP2) {
            PG8_LDB(B0, 0, 0); PG8_LDB(B1, 0, 1); PG8_SCHED; PG8_LDA(At, 0, 0); PG8_STAGE(PG8_SA(1, 1), a1 + hstep, voffA);
            PG8_WAIT_V(8); PG8_WAIT_L(0); PG8_BAR; PG8_MMA(0, 0, At, B0); PG8_MMA(0, 1, At, B1); PG8_BAR; PG8_SCHED;
            PG8_LDA(At, 0, 1); PG8_STAGE(PG8_SB(0, 0), b2, voffB); PG8_STAGE(PG8_SB(0, 1), b2 + hstep, voffB); PG8_STAGE(PG8_SA(0, 0), a2, voffA);
            PG8_WAIT_V(8); PG8_WAIT_L(0); PG8_BAR; PG8_MMA(1, 0, At, B0); PG8_MMA(1, 1, At, B1); PG8_BAR; PG8_SCHED;
            PG8_LDB(B0, 1, 0); PG8_LDB(B1, 1, 1); PG8_SCHED; PG8_LDA(At, 1, 0); PG8_STAGE(PG8_SA(0, 1), a2 + hstep, voffA);
            PG8_WAIT_V(8); PG8_WAIT_L(0); PG8_BAR; PG8_MMA(0, 0, At, B0); PG8_MMA(0, 1, At, B1); PG8_BAR; PG8_SCHED;
            PG8_LDA(At, 1, 1); PG8_STAGE(PG8_SB(1, 0), b3, voffB); PG8_STAGE(PG8_SB(1, 1), b3 + hstep, voffB); PG8_STAGE(PG8_SA(1, 0), a3, voffA);
            PG8_WAIT_V(8); PG8_WAIT_L(0); PG8_BAR; PG8_MMA(1, 0, At, B0); PG8_MMA(1, 1, At, B1); PG8_BAR; PG8_SCHED;
            } else {
            PG8_LDB(B0, 0, 0); PG8_SCHED; PG8_LDA(At, 0, 0); PG8_STAGE(PG8_SA(1, 1), a1 + hstep, voffA);
            PG8_WAIT_L(8); PG8_BAR; PG8_WAIT_L(0); PG8_MMA(0, 0, At, B0); PG8_BAR; PG8_SCHED;
            PG8_LDB(B1, 0, 1); PG8_STAGE(PG8_SB(0, 0), b2, voffB);
            PG8_BAR; PG8_WAIT_L(0); PG8_MMA(0, 1, At, B1); PG8_BAR;
            PG8_LDA(At, 0, 1); PG8_STAGE(PG8_SA(0, 0), a2, voffA);
            PG8_BAR; PG8_WAIT_L(0); PG8_MMA(1, 0, At, B0); PG8_BAR; PG8_SCHED;
            PG8_STAGE(PG8_SB(0, 1), b2 + hstep, voffB);
            PG8_WAIT_V(6); PG8_BAR; PG8_MMA(1, 1, At, B1); PG8_BAR;
            PG8_LDB(B0, 1, 0); PG8_SCHED; PG8_LDA(At, 1, 0); PG8_STAGE(PG8_SA(0, 1), a2 + hstep, voffA);
            PG8_WAIT_L(8); PG8_BAR; PG8_WAIT_L(0); PG8_MMA(0, 0, At, B0); PG8_BAR; PG8_SCHED;
            PG8_LDB(B1, 1, 1); PG8_STAGE(PG8_SB(1, 0), b3, voffB);
            PG8_BAR; PG8_WAIT_L(0); PG8_MMA(0, 1, At, B1); PG8_BAR;
            PG8_LDA(At, 1, 1); PG8_STAGE(PG8_SA(1, 0), a3, voffA);
            PG8_BAR; PG8_WAIT_L(0); PG8_MMA(1, 0, At, B0); PG8_BAR; PG8_SCHED;
            PG8_STAGE(PG8_SB(1, 1), b3 + hstep, voffB);
            PG8_WAIT_V(6); PG8_BAR; PG8_MMA(1, 1, At, B1); PG8_BAR;
            }
        }
        if constexpr (ALIGN_EPI) { if (wr == 0) PG8_BAR; }
        if constexpr (!Epi::AFTER_DRAIN) { E(acc, cur, wr, wc, fr, fq); S.done(cur); }
        if (!has_next) break;
#pragma unroll
        for (int a = 0; a < 2; ++a)
#pragma unroll
            for (int b = 0; b < 2; ++b)
#pragma unroll
                for (int m = 0; m < 4; ++m)
#pragma unroll
                    for (int n = 0; n < 2; ++n) acc[a][b][m][n] = (f32x4){0.f, 0.f, 0.f, 0.f};
        cur = nxt; cA = nA; cB = nB; ++ui;
        if constexpr (ALIGN_EPI) { if (wr == 1) PG8_BAR; }
    }
    PG8_WAIT_V(0);
    if constexpr (!ALIGN_EPI) { if (wr == 0) PG8_BAR; }
    PG8_BAR;
    if constexpr (Epi::AFTER_DRAIN) { E.fused(acc, cur, wr, wc, fr, fq, lds, wid, lane); S.done(cur); }
#undef PG8_SA
#undef PG8_SB
#undef PG8_STAGE
#undef PG8_LDA
#undef PG8_LDB
#undef PG8_MMA
#undef PG8_WAIT_V
#undef PG8_WAIT_L
#undef PG8_BAR
#undef PG8_SCHED
}
}

constexpr int NWAVES = 8, NTHREADS = NWAVES * 64;
constexpr int N_LAUNCHES = MK_N_LAUNCHES;
constexpr int N_PHASES = 8;
constexpr int BATCH = 8, SEQ = 2048, D = 2048, M = BATCH * SEQ;
constexpr int HD = 64, NQH = 32, NKVH = 4, GQA = 8, WIN = 128;
constexpr int GH = 4, GDK = 256, GDV = 512, GRANK = 16, GCHUNK = 64;
constexpr int FF = 5632;
constexpr int DIN = 12816;
constexpr int PW = 12800;
constexpr int NP1 = 13056;
constexpr int C_AQ = 0, C_AK = 2048, C_AV = 2304, C_GQ = 2560, C_GK = 3584, C_GV = 4608, C_GR = 6656, C_GA = 8704, C_GB = 10752;
constexpr int SRC_GLR = 6656;
constexpr float RMS_EPS = 1e-6f;

constexpr size_t MiB = 1u << 20;
constexpr size_t WS_CTL = 0, CTL_ZERO_BYTES = 64 * 1024;
constexpr size_t WS_RSTD1 = 1 * MiB;
constexpr size_t WS_GLR = 2 * MiB;
constexpr size_t WS_DEC = 3 * MiB;
constexpr size_t WS_SSQG = 4 * MiB;
constexpr size_t WS_SSQ2 = 6 * MiB;
constexpr size_t WS_SSQ3 = 8 * MiB;
constexpr size_t WS_WOUT = 10 * MiB;
constexpr size_t WS_WDOWN = 18 * MiB;
constexpr size_t WS_WIN = 40 * MiB;
constexpr size_t WS_PROJ = 92 * MiB;
constexpr size_t WS_H1 = WS_PROJ;
constexpr size_t WS_H1B = WS_PROJ + 128 * MiB;
constexpr size_t WS_FF = WS_PROJ + 192 * MiB;
constexpr size_t WS_END = 492 * MiB;
static_assert(WS_WIN + (size_t)NP1 * D * 2 <= WS_PROJ && WS_PROJ + (size_t)M * PW * 2 <= WS_END && WS_FF + (size_t)M * FF * 2 <= WS_END && WS_WDOWN + (size_t)D * FF * 2 <= WS_WIN, "ws map");
constexpr size_t OUT_XB = 0;
constexpr size_t OUT_WGU = 64 * MiB;
constexpr int CW_BAR = 1024;

constexpr int RING_BYTES = 131072, LDSCTL_OFF = RING_BYTES, MISC_OFF = LDSCTL_OFF + 320, LDS_BYTES = 147456;

#define GAS __attribute__((address_space(1)))
#define LAS __attribute__((address_space(3)))
typedef unsigned short bf16;
typedef unsigned v4u __attribute__((ext_vector_type(4)));
typedef unsigned v2u __attribute__((ext_vector_type(2)));
typedef float f32x4 __attribute__((ext_vector_type(4)));
typedef GAS unsigned gu32;
#define LDS_WAIT() asm volatile("s_waitcnt lgkmcnt(0)" ::: "memory")
#define VM_WAIT() asm volatile("s_waitcnt vmcnt(0)" ::: "memory")
__device__ __forceinline__ unsigned f2bf(float f) { unsigned u = __builtin_bit_cast(unsigned, f); return (u + 0x7fffu + ((u >> 16) & 1u)) >> 16; }
__device__ __forceinline__ unsigned pk2(float lo, float hi) { return f2bf(lo) | (f2bf(hi) << 16); }
__device__ __forceinline__ float bf2f(unsigned short b) { return __builtin_bit_cast(float, (unsigned)b << 16); }
__device__ __forceinline__ float bflo(unsigned w) { return __builtin_bit_cast(float, w << 16); }
__device__ __forceinline__ float bfhi(unsigned w) { return __builtin_bit_cast(float, w & 0xffff0000u); }
__device__ __forceinline__ float sigmoidf_(float x) { return 1.0f / (1.0f + __expf(-x)); }

#define XB_TMO      128
#define XB_XCNT(j)  (256  + 64 * (j))
#define XB_XSUB(j)  (1280 + 64 * (j))
#define XB_XGEN(j)  (2304 + 64 * (j))
#define XB_TOP      3328
#define XB_TOPGEN   3392
#define XCD_BAR_WORDS 3456
#define XB_SPIN_CAP (1u << 22)
static_assert((CW_BAR + XCD_BAR_WORDS) * 4 <= (int)CTL_ZERO_BYTES, "barrier words inside the memset region");

__device__ __forceinline__ unsigned xb_ld(unsigned* p)              { return __hip_atomic_load(p, __ATOMIC_RELAXED, __HIP_MEMORY_SCOPE_AGENT); }
__device__ __forceinline__ unsigned xb_add(unsigned* p, unsigned v) { return __hip_atomic_fetch_add(p, v, __ATOMIC_RELAXED, __HIP_MEMORY_SCOPE_AGENT); }
__device__ __forceinline__ unsigned xb_xcc_id() { return (unsigned)__builtin_amdgcn_s_getreg((3 << 11) | 20) & 0xFu; }
#define XB_SPIN(cond, bar) do { unsigned _sp = 0; while (cond) { __builtin_amdgcn_s_sleep(1); \
    if ((++_sp & 255u) == 0u) { if (xb_ld(&(bar)[XB_TMO])) break; if (_sp > XB_SPIN_CAP) { atomicAdd(&(bar)[XB_TMO], 1u); break; } } } } while (0)

struct XcdBarrier { unsigned* bar; unsigned x; volatile LAS unsigned* st; };

__device__ __forceinline__ XcdBarrier xcd_barrier_post(unsigned* bar, volatile LAS unsigned* st) {
    XcdBarrier b; b.bar = bar; b.x = xb_xcc_id(); b.st = st;
    if (threadIdx.x == 0) (void)xb_add(&bar[XB_XCNT(b.x)], 1u);
    return b;
}
__device__ __forceinline__ void xcd_barrier_complete(unsigned* bar, unsigned x, unsigned& nloc, unsigned& nx) {
    const unsigned G = gridDim.x * gridDim.y * gridDim.z;
    unsigned sum, cnt, mine, sp = 0u;
    for (;;) {
        sum = 0u; cnt = 0u; mine = 0u;
#pragma unroll
        for (unsigned j = 0; j < 16; ++j) { const unsigned c = xb_ld(&bar[XB_XCNT(j)]); sum += c; cnt += (c > 0u) ? 1u : 0u; mine = (j == x) ? c : mine; }
        if (sum == G) break;
        __builtin_amdgcn_s_sleep(1);
        if ((++sp & 255u) == 0u) { if (xb_ld(&bar[XB_TMO])) break; if (sp > XB_SPIN_CAP) { atomicAdd(&bar[XB_TMO], 1u); break; } }
    }
    nloc = mine > 0u ? mine : 1u; nx = cnt > 0u ? cnt : 1u;
}
__device__ __forceinline__ void xcd_barrier(const XcdBarrier& b) {
    asm volatile("s_waitcnt vmcnt(0)" ::: "memory");
    __syncthreads();
    if (threadIdx.x == 0) {
        unsigned* bar = b.bar;
        __builtin_amdgcn_s_waitcnt(0);
        unsigned nloc = b.st[0], nx = b.st[1];
        if (nloc == 0u) { xcd_barrier_complete(bar, b.x, nloc, nx); b.st[0] = nloc; b.st[1] = nx; }
        const unsigned old = xb_add(&bar[XB_XSUB(b.x)], 1u);
        const unsigned gen = old / nloc;
        if (old + 1u == (gen + 1u) * nloc) {
            __builtin_amdgcn_fence(__ATOMIC_RELEASE, "agent");
            asm volatile("s_waitcnt vmcnt(0)" ::: "memory");
            const unsigned og = xb_add(&bar[XB_TOP], 1u);
            const unsigned tg = og / nx;
            if (og + 1u == (tg + 1u) * nx) xb_add(&bar[XB_TOPGEN], 1u);
            else XB_SPIN(xb_ld(&bar[XB_TOPGEN]) == tg, bar);
            __builtin_amdgcn_fence(__ATOMIC_ACQUIRE, "agent");
            xb_add(&bar[XB_XGEN(b.x)], 1u);
            asm volatile("s_waitcnt vmcnt(0)" ::: "memory");
        } else {
            XB_SPIN(xb_ld(&bar[XB_XGEN(b.x)]) == gen, bar);
            __builtin_amdgcn_fence(__ATOMIC_ACQUIRE, "agent");
            asm volatile("s_waitcnt vmcnt(0)" ::: "memory");
        }
    }
    __syncthreads();
}

struct Frame {
    LAS unsigned char* lds;
    volatile LAS unsigned* MISC;
    gu32* ctl;
    int tid, lane, wave, vcu, G;
    const float *x, *norm1_w, *w_in, *gate_w2, *gate_b, *sinks, *gnorm_w, *w_out, *norm2_w, *w_gate, *w_up, *w_down, *fnorm_w;
    float* out;
    unsigned char* ws;
    bf16 *Win_t, *Wout_t, *Wgu_t, *Wdown_t, *XB, *PROJ, *MERGED, *H1B, *FFB;
    float *RSTD1, *GLR, *DEC, *SSQG, *SSQ2, *SSQ3, *H1;
};

__device__ __forceinline__ float wave_sum(float v) {
#pragma unroll
    for (int o = 1; o < 64; o <<= 1) v += __shfl_xor(v, o);
    return v;
}

__device__ __forceinline__ void p0_transpose_item(const float* W, int ldw, int srccol, const float* kscale, int K, bf16* WTrow0, LAS float* scr, int k0, int lane) {
#pragma unroll 8
    for (int i = 0; i < 32; ++i) { const int kk = 2 * i + (lane >> 5); float v = 0.f;
        if (srccol >= 0) v = W[(size_t)(k0 + kk) * ldw + srccol];
        if (kscale) v *= kscale[k0 + kk];
        scr[kk * 33 + (lane & 31)] = v; }
    LDS_WAIT(); asm volatile("" ::: "memory");
    const int c = lane & 7;
#pragma unroll
    for (int j = 0; j < 4; ++j) { const int n = (lane >> 3) + 8 * j; const LAS float* s = scr + (8 * c) * 33 + n;
        v4u o; o.x = pk2(s[0 * 33], s[1 * 33]); o.y = pk2(s[2 * 33], s[3 * 33]); o.z = pk2(s[4 * 33], s[5 * 33]); o.w = pk2(s[6 * 33], s[7 * 33]);
        *(GAS v4u*)(WTrow0 + (size_t)n * K + k0 + 8 * c) = o; }
    LDS_WAIT(); asm volatile("" ::: "memory");
}
__device__ __forceinline__ void p0_prologue(Frame& F) {
    LAS float* scr = (LAS float*)(F.lds + F.wave * 16384);
    const int gw = F.vcu * NWAVES + F.wave, NGW = F.G * NWAVES;
    constexpr int I_IN = (D / 64) * (NP1 / 32), I_OUT = (D / 64) * (D / 32), I_GU = (D / 64) * (2 * FF / 32), I_DN = (FF / 64) * (D / 32);
    constexpr int NITEMS = I_IN + I_OUT + I_GU + I_DN;
    const int l31 = F.lane & 31;
    for (int it = gw; it < NITEMS; it += NGW) {
        int r = it;
        if (r < I_IN) { const int nblk = NP1 / 32, kb = r / nblk, nb = r % nblk, n = nb * 32 + l31;
            const int sc = n < SRC_GLR ? n : (n < PW ? n + GRANK : (n < PW + GRANK ? SRC_GLR + (n - PW) : -1));
            p0_transpose_item(F.w_in, DIN, sc, F.norm1_w, D, F.Win_t + (size_t)(nb * 32) * D, scr, kb * 64, F.lane); continue; }
        r -= I_IN;
        if (r < I_OUT) { const int nblk = D / 32, kb = r / nblk, nb = r % nblk;
            p0_transpose_item(F.w_out, D, nb * 32 + l31, nullptr, D, F.Wout_t + (size_t)(nb * 32) * D, scr, kb * 64, F.lane); continue; }
        r -= I_OUT;
        if (r < I_GU) { const int nblk = 2 * FF / 32, kb = r / nblk, nb = r % nblk, n0 = nb * 32, pn = n0 >> 8, bj = (n0 >> 7) & 1, hl = (n0 & 127) + l31;
            p0_transpose_item(bj ? F.w_up : F.w_gate, FF, pn * 128 + hl, F.norm2_w, D, F.Wgu_t + (size_t)n0 * D, scr, kb * 64, F.lane); continue; }
        r -= I_GU;
        { const int nblk = D / 32, kb = r / nblk, nb = r % nblk;
            p0_transpose_item(F.w_down, D, nb * 32 + l31, nullptr, FF, F.Wdown_t + (size_t)(nb * 32) * FF, scr, kb * 64, F.lane); }
    }
    for (int m = gw; m < M; m += NGW) {
        const GAS f32x4* xr = (const GAS f32x4*)(F.x + (size_t)m * D) + F.lane;
        f32x4 v[8]; float s = 0.f;
#pragma unroll
        for (int j = 0; j < 8; ++j) { v[j] = xr[64 * j]; s += (v[j].x * v[j].x + v[j].y * v[j].y) + (v[j].z * v[j].z + v[j].w * v[j].w); }
        s = wave_sum(s);
        if (F.lane == 0) F.RSTD1[m] = 1.0f / sqrtf(s * (1.0f / D) + RMS_EPS);
        GAS v2u* o8 = (GAS v2u*)(F.XB + (size_t)m * D) + F.lane;
#pragma unroll
        for (int j = 0; j < 8; ++j) { v2u w; w.x = pk2(v[j].x, v[j].y); w.y = pk2(v[j].z, v[j].w); o8[64 * j] = w; }
    }
}

__device__ __forceinline__ void p2_gla_naive(Frame& F) {
    float* al = (float*)(F.lds);
    float* kk = al + 256;
    float* qq = kk + 256;
    float* vv = qq + 256;
    float* red = vv + 64;
    const int tid = F.tid, lane = F.lane, wave = F.wave;
    const int vl = tid >> 3, dq = tid & 7;
    for (int unit = blockIdx.x; unit < BATCH * GH * 8; unit += gridDim.x) {
        const int b = unit >> 5, h = (unit >> 3) & 3, vs = unit & 7;
        float S[32];
#pragma unroll
        for (int d = 0; d < 32; ++d) S[d] = 0.f;
        float w2r[16]; float bias = 0.f;
        const int dch = tid & 255;
#pragma unroll
        for (int r = 0; r < 16; ++r) w2r[r] = F.gate_w2[r * (GH * GDK) + h * GDK + dch];
        bias = F.gate_b[h * GDK + dch];
        for (int t = 0; t < SEQ; ++t) {
            const size_t row = (size_t)b * SEQ + t;
            const bf16* prow = F.PROJ + row * PW;
            if (tid < 256) {
                const f32x4* g4 = (const f32x4*)(F.GLR + row * 16);
                float logit = bias;
#pragma unroll
                for (int r4 = 0; r4 < 4; ++r4) { const f32x4 g = g4[r4]; logit += g[0] * w2r[4 * r4] + g[1] * w2r[4 * r4 + 1] + g[2] * w2r[4 * r4 + 2] + g[3] * w2r[4 * r4 + 3]; }
                const float ls = fminf(logit, 0.f) - log1pf(expf(-fabsf(logit)));
                al[tid] = expf(ls * (1.0f / 16.0f));
                qq[tid] = bf2f(prow[C_GQ + h * GDK + tid]) * (1.0f / 16.0f);
                kk[tid] = bf2f(prow[C_GK + h * GDK + tid]);
            } else if (tid < 320) {
                vv[tid - 256] = bf2f(prow[C_GV + h * GDV + vs * 64 + (tid - 256)]);
            }
            __syncthreads();
            const float v = vv[vl]; float acc = 0.f;
#pragma unroll
            for (int d = 0; d < 32; ++d) { const int dd = dq * 32 + d; S[d] = al[dd] * S[d] + kk[dd] * v; acc += qq[dd] * S[d]; }
            acc += __shfl_xor(acc, 1); acc += __shfl_xor(acc, 2); acc += __shfl_xor(acc, 4);
            const float ob = bf2f((unsigned short)f2bf(acc));
            float o2 = ob * ob;
            o2 += __shfl_xor(o2, 8); o2 += __shfl_xor(o2, 16); o2 += __shfl_xor(o2, 32);
            if (lane == 0) red[wave] = o2;
            if (dq == 0) ((bf16*)prow)[C_GV + h * GDV + vs * 64 + vl] = (bf16)f2bf(acc);
            __syncthreads();
            if (tid == 0) { float s = 0.f;
#pragma unroll
                for (int w = 0; w < 8; ++w) s += red[w];
                F.SSQG[row * 32 + h * 8 + vs] = s; }
        }
        __syncthreads();
    }
}

__device__ __forceinline__ void p3_attn_naive(Frame& F) {
    constexpr int KST = 66;
    bf16* Ks = (bf16*)F.lds;
    bf16* Vs = Ks + 256 * KST;
    const int tid = F.tid;
    for (int unit = blockIdx.x; unit < BATCH * 16 * NKVH; unit += gridDim.x) {
        const int b = unit >> 6, nb = (unit >> 2) & 15, kvh = unit & 3;
        __syncthreads();
        for (int c = tid; c < 256 * 32; c += NTHREADS) {
            const int j = c >> 5, w = c & 31; const int tok = (nb - 1) * WIN + j;
            unsigned kw = 0u, vw = 0u;
            if (tok >= 0) { const bf16* prow = F.PROJ + ((size_t)b * SEQ + tok) * PW;
                kw = *(const unsigned*)(prow + C_AK + kvh * HD + 2 * w); vw = *(const unsigned*)(prow + C_AV + kvh * HD + 2 * w); }
            *(unsigned*)(Ks + j * KST + 2 * w) = kw; *(unsigned*)(Vs + j * KST + 2 * w) = vw;
        }
        __syncthreads();
        const int g = tid >> 6, hq = kvh * GQA + g;
        const float sink = F.sinks[hq];
        for (int rep = 0; rep < 2; ++rep) {
            const int i = (tid & 63) + 64 * rep;
            const size_t row = (size_t)b * SEQ + nb * WIN + i;
            const bf16* prow = F.PROJ + row * PW;
            float q[64], o[64];
#pragma unroll
            for (int d2 = 0; d2 < 32; ++d2) { const unsigned w = *(const unsigned*)(prow + C_AQ + hq * HD + 2 * d2); q[2 * d2] = bflo(w) * 0.125f; q[2 * d2 + 1] = bfhi(w) * 0.125f; o[2 * d2] = 0.f; o[2 * d2 + 1] = 0.f; }
            float mx = sink, l = 1.0f;
            for (int jj = 1; jj <= WIN; ++jj) {
                const int ki = i + jj;
                if (nb == 0 && ki < WIN) continue;
                const unsigned* kr = (const unsigned*)(Ks + ki * KST);
                float s = 0.f;
#pragma unroll
                for (int d2 = 0; d2 < 32; ++d2) { const unsigned w = kr[d2]; s += q[2 * d2] * bflo(w) + q[2 * d2 + 1] * bfhi(w); }
                const float mn = fmaxf(mx, s), sc = __expf(mx - mn), p = __expf(s - mn);
                l = l * sc + p; mx = mn;
                const unsigned* vr = (const unsigned*)(Vs + ki * KST);
#pragma unroll
                for (int d2 = 0; d2 < 32; ++d2) { const unsigned w = vr[d2]; o[2 * d2] = o[2 * d2] * sc + p * bflo(w); o[2 * d2 + 1] = o[2 * d2 + 1] * sc + p * bfhi(w); }
            }
            const float il = 1.0f / l;
            float sg = 0.f;
#pragma unroll
            for (int s8 = 0; s8 < 8; ++s8) sg += F.SSQG[row * 32 + kvh * 8 + s8];
            const float rg = 1.0f / sqrtf(sg * (1.0f / GDV) + RMS_EPS);
            const int cb = hq * HD;
            bf16* mrow = F.MERGED + row * D + cb;
#pragma unroll
            for (int d2 = 0; d2 < 32; ++d2) {
                const unsigned wa = *(const unsigned*)(prow + C_GA + cb + 2 * d2), wb = *(const unsigned*)(prow + C_GB + cb + 2 * d2);
                const unsigned wr_ = *(const unsigned*)(prow + C_GR + cb + 2 * d2), wg = *(const unsigned*)(prow + C_GV + cb + 2 * d2);
                const float gr0 = bflo(wr_), gr1 = bfhi(wr_);
                const float gl0 = bflo(wg) * rg * F.gnorm_w[g * HD + 2 * d2] * (gr0 * sigmoidf_(gr0));
                const float gl1 = bfhi(wg) * rg * F.gnorm_w[g * HD + 2 * d2 + 1] * (gr1 * sigmoidf_(gr1));
                const float m0 = sigmoidf_(bflo(wa)) * (o[2 * d2] * il) + sigmoidf_(bflo(wb)) * gl0;
                const float m1 = sigmoidf_(bfhi(wa)) * (o[2 * d2 + 1] * il) + sigmoidf_(bfhi(wb)) * gl1;
                *(unsigned*)(mrow + 2 * d2) = pk2(m0, m1);
            }
        }
    }
    __syncthreads();
}

__device__ __forceinline__ void p7_final_norm(Frame& F) {
    const int gw = F.vcu * NWAVES + F.wave, NGW = F.G * NWAVES;
    f32x4 wv[8];
#pragma unroll
    for (int j = 0; j < 8; ++j) wv[j] = ((const f32x4*)F.fnorm_w)[F.lane + 64 * j];
    for (int m = gw; m < M; m += NGW) {
        float s = (F.lane < 32) ? F.SSQ3[(size_t)m * 32 + F.lane] : 0.f;
        s = wave_sum(s);
        const float rs = 1.0f / sqrtf(s * (1.0f / D) + RMS_EPS);
        GAS f32x4* xr = (GAS f32x4*)(F.out + (size_t)m * D) + F.lane;
#pragma unroll
        for (int j = 0; j < 8; ++j) { f32x4 v = xr[64 * j]; v = v * rs * wv[j]; xr[64 * j] = v; }
    }
}

struct Args { const float* in[13]; float* out; unsigned char* ws; int ph_lo, ph_hi; };
__global__ void __launch_bounds__(NTHREADS, 2) hybrid_fwd(Args args) {
    extern __shared__ __attribute__((aligned(16))) unsigned char lds[];
    Frame F;
    F.lds = (LAS unsigned char*)lds;
    F.MISC = (volatile LAS unsigned*)(F.lds + MISC_OFF);
    F.tid = threadIdx.x; F.lane = F.tid & 63; F.wave = __builtin_amdgcn_readfirstlane(F.tid >> 6);
    F.G = gridDim.x; { const int bx = blockIdx.x; F.vcu = (F.G % 8 == 0) ? (bx % 8) * (F.G / 8) + bx / 8 : bx; }
    unsigned char* ws = args.ws;
    F.ws = ws; F.ctl = (gu32*)(ws + WS_CTL);
    F.x = args.in[0]; F.norm1_w = args.in[1]; F.w_in = args.in[2]; F.gate_w2 = args.in[3]; F.gate_b = args.in[4]; F.sinks = args.in[5]; F.gnorm_w = args.in[6];
    F.w_out = args.in[7]; F.norm2_w = args.in[8]; F.w_gate = args.in[9]; F.w_up = args.in[10]; F.w_down = args.in[11]; F.fnorm_w = args.in[12];
    F.out = args.out;
    F.Win_t = (bf16*)(ws + WS_WIN); F.Wout_t = (bf16*)(ws + WS_WOUT); F.Wdown_t = (bf16*)(ws + WS_WDOWN); F.Wgu_t = (bf16*)((unsigned char*)args.out + OUT_WGU);
    F.XB = (bf16*)((unsigned char*)args.out + OUT_XB); F.MERGED = F.XB; F.PROJ = (bf16*)(ws + WS_PROJ); F.H1B = (bf16*)(ws + WS_H1B); F.FFB = (bf16*)(ws + WS_FF);
    F.RSTD1 = (float*)(ws + WS_RSTD1); F.GLR = (float*)(ws + WS_GLR); F.DEC = (float*)(ws + WS_DEC); F.SSQG = (float*)(ws + WS_SSQG); F.SSQ2 = (float*)(ws + WS_SSQ2); F.SSQ3 = (float*)(ws + WS_SSQ3);
    F.H1 = (float*)(ws + WS_H1);
    for (int u = F.tid; u < (LDS_BYTES - LDSCTL_OFF) / 4; u += NTHREADS) ((LAS unsigned*)(F.lds + LDSCTL_OFF))[u] = 0u;
    __syncthreads();
    XcdBarrier bar; bar.bar = (unsigned*)(F.ctl + CW_BAR); bar.x = 0; bar.st = nullptr;
    if (N_LAUNCHES == 1) bar = xcd_barrier_post((unsigned*)(F.ctl + CW_BAR), F.MISC + 8);
    const int lo = args.ph_lo, hi = args.ph_hi;
#define IN(k) (lo <= (k) && (k) < hi)
#define SEAM(k) do { if (IN(k) && IN((k) + 1)) xcd_barrier(bar); } while (0)

    if (IN(0)) { p0_prologue(F); SEAM(0); }
    if (IN(1)) {
        pg8::Gemm g{F.XB, F.Win_t, M, NP1, D}; pg8::StaticOrder S; S.init(M, NP1, F.G, (int)blockIdx.x);
        pg8::EpiProj E{F.PROJ, PW, F.RSTD1, F.GLR, PW / 256};
        pg8::gemm_phase<pg8::EpiProj, pg8::StaticOrder, true, true>(F.lds, g, S, E);
        SEAM(1);
    }
    if (IN(2)) { p2_gla_naive(F); SEAM(2); }
    if (IN(3)) { p3_attn_naive(F); SEAM(3); }
    if (IN(4)) {
        pg8::Gemm g{F.MERGED, F.Wout_t, M, D, D}; pg8::StaticOrder S; S.init(M, D, F.G, (int)blockIdx.x);
        pg8::EpiRes E{F.x, F.H1, F.H1B, D, F.SSQ2};
        pg8::gemm_phase<pg8::EpiRes, pg8::StaticOrder, true, true>(F.lds, g, S, E);
        SEAM(4);
    }
    if (IN(5)) {
        pg8::Gemm g{F.H1B, F.Wgu_t, M, 2 * FF, D}; pg8::StaticOrder S; S.init(M, 2 * FF, F.G, (int)blockIdx.x);
        pg8::EpiSwiGLU E{F.FFB, FF, F.SSQ2, 1.0f / D};
        pg8::gemm_phase<pg8::EpiSwiGLU, pg8::StaticOrder, true, true>(F.lds, g, S, E);
        SEAM(5);
    }
    if (IN(6)) {
        pg8::Gemm g{F.FFB, F.Wdown_t, M, D, FF}; pg8::StaticOrder S; S.init(M, D, F.G, (int)blockIdx.x);
        pg8::EpiRes E{F.H1, F.out, nullptr, D, F.SSQ3};
        pg8::gemm_phase<pg8::EpiRes, pg8::StaticOrder, true, true>(F.lds, g, S, E);
        SEAM(6);
    }
    if (IN(7)) { p7_final_norm(F); }
#undef IN
#undef SEAM
}

extern "C" void kernel_launch(void* const* d_in, const int* in_sizes, int n_in, void* d_out, int out_size, void* d_ws, size_t ws_size, hipStream_t stream) {
    static int grid = 0;
    if (grid == 0) {
        if (n_in != 13 || in_sizes[0] != M * D || out_size != M * D || ws_size < WS_END) { fprintf(stderr, "kernel_launch: unexpected shapes (n_in %d, in0 %d, out %d, ws %zu)\n", n_in, n_in > 0 ? in_sizes[0] : -1, out_size, ws_size); grid = -1; return; }
        int dev = 0, cus = 0, per_cu = 0;
        if (hipGetDevice(&dev) != hipSuccess || hipDeviceGetAttribute(&cus, hipDeviceAttributeMultiprocessorCount, dev) != hipSuccess) { grid = -1; return; }
        if (hipFuncSetAttribute((const void*)hybrid_fwd, hipFuncAttributeMaxDynamicSharedMemorySize, LDS_BYTES) != hipSuccess) { fprintf(stderr, "kernel_launch: hipFuncSetAttribute failed\n"); grid = -1; return; }
        if (hipOccupancyMaxActiveBlocksPerMultiprocessor(&per_cu, (const void*)hybrid_fwd, NTHREADS, LDS_BYTES) != hipSuccess || per_cu < 1) { fprintf(stderr, "kernel_launch: occupancy query reports %d\n", per_cu); }
        (void)hipGetLastError();
        grid = cus;
    }
    if (grid < 0) return;
    (void)hipMemsetAsync((char*)d_ws + WS_CTL, 0, CTL_ZERO_BYTES, stream);
    Args a{};
    for (int i = 0; i < 13; ++i) a.in[i] = (const float*)d_in[i];
    a.out = (float*)d_out; a.ws = (unsigned char*)d_ws;
    if (N_LAUNCHES == 1) { a.ph_lo = 0; a.ph_hi = N_PHASES; hipLaunchKernelGGL(hybrid_fwd, dim3(grid), dim3(NTHREADS), LDS_BYTES, stream, a); }
    else for (int li = 0; li < N_PHASES; ++li) { a.ph_lo = li; a.ph_hi = li + 1; hipLaunchKernelGGL(hybrid_fwd, dim3(grid), dim3(NTHREADS), LDS_BYTES, stream, a); }
}
```

```cpp
#include <hip/hip_runtime.h>
#include <cstdio>
#include <cstdint>

#ifndef MK_N_LAUNCHES
#define MK_N_LAUNCHES 1
#endif

namespace pg8 {
#define PG8_LAS __attribute__((address_space(3)))
typedef unsigned short bf16_t;
typedef short bf16x8 __attribute__((ext_vector_type(8)));
typedef float f32x4 __attribute__((ext_vector_type(4)));
typedef unsigned u32x4 __attribute__((ext_vector_type(4)));
constexpr int BM = 256, BK = 64, HALF = 128, HTB = HALF * BK * 2  , STAGE_BYTES = 8 * HTB, NXCD = 8, WGM = 8;

__host__ __device__ __forceinline__ int lds_byte(int r, int c) { const int st = (r >> 4) * 2 + (c >> 5), rr = r & 15, cc = c & 31, ob = rr * 64 + cc * 2; return st * 1024 + (ob ^ (((ob >> 9) & 1) << 5)); }
__host__ __device__ __forceinline__ void stage_rc(int b, int& R, int& C) { const int st = b / 1024, sb = b % 1024, swz = sb ^ (((sb >> 9) & 1) << 5); R = (st >> 1) * 16 + swz / 64; C = (st & 1) * 32 + (swz % 64) / 2; }
__host__ __device__ __forceinline__ int perm32(int rho) { const int n = rho >> 4, i = rho & 15; return 8 * (i >> 2) + 4 * n + (i & 3); }

struct Unit { int pm, pn; };
struct Gemm { const bf16_t* A; const bf16_t* Bt; int M, N, K; };

struct StaticOrder {
    int nM, nN, nwg, G, c;
    __host__ __device__ void init(int M, int N, int G_, int c_) { nM = M / BM; nN = N / BM; nwg = nM * nN; G = G_; c = c_; }
    __host__ __device__ bool next(int i, Unit& u) const {
        const long L = (long)i * G + c; if (L >= nwg) return false;
        int wgid = (int)L; { const int q = nwg / NXCD, r = nwg % NXCD, xcd = wgid % NXCD, off = wgid / NXCD; wgid = (xcd < r ? xcd * (q + 1) : r * (q + 1) + (xcd - r) * q) + off; }
        const int nig = WGM * nN, gid = wgid / nig, fm = gid * WGM, gsz = (nM - fm) < WGM ? (nM - fm) : WGM;
        u.pm = fm + ((wgid % nig) % gsz); u.pn = (wgid % nig) / gsz; return true;
    }
    __device__ __forceinline__ void a_ready(const Unit&) const {}
    __device__ __forceinline__ void done(const Unit&) const {}
};

__device__ __forceinline__ unsigned cvt_pk_bf16(float lo, float hi) { unsigned r; asm volatile("v_cvt_pk_bf16_f32 %0, %1, %2" : "=v"(r) : "v"(lo), "v"(hi)); return r; }
__device__ __forceinline__ float sum4(const f32x4 v) { return (v[0] + v[1]) + (v[2] + v[3]); }
__device__ __forceinline__ float sq4(const f32x4 v) { return (v[0] * v[0] + v[1] * v[1]) + (v[2] * v[2] + v[3] * v[3]); }
constexpr float RMS_EPS = 1e-6f;

struct EpiProj {
    static constexpr bool PERM = true, AFTER_DRAIN = false;
    bf16_t* O; int ldc; const float* rstd; float* glr; int glr_tile;
    __device__ __forceinline__ void operator()(const f32x4 (&acc)[2][2][4][2], const Unit& u, int wr, int wc, int fr, int fq) const {
        const int row0 = u.pm * BM + wr * 64 + fr;
        float rs[2][4];
#pragma unroll
        for (int ai = 0; ai < 2; ++ai)
#pragma unroll
            for (int m = 0; m < 4; ++m) rs[ai][m] = rstd[row0 + ai * HALF + m * 16];
        if (u.pn == glr_tile) {
            if (wc == 0 && fq < 2) {
#pragma unroll
                for (int ai = 0; ai < 2; ++ai)
#pragma unroll
                    for (int m = 0; m < 4; ++m) { float* p = glr + (size_t)(row0 + ai * HALF + m * 16) * 16 + 8 * fq;
                        *(f32x4*)p = acc[ai][0][m][0] * rs[ai][m]; *(f32x4*)(p + 4) = acc[ai][0][m][1] * rs[ai][m]; }
            }
            return;
        }
        const int col0 = u.pn * BM + wc * 32 + 8 * fq;
#pragma unroll
        for (int ai = 0; ai < 2; ++ai)
#pragma unroll
            for (int m = 0; m < 4; ++m) { bf16_t* rowp = O + (size_t)(row0 + ai * HALF + m * 16) * ldc + col0; const float s = rs[ai][m];
#pragma unroll
                for (int bj = 0; bj < 2; ++bj) { const f32x4 v0 = acc[ai][bj][m][0] * s, v1 = acc[ai][bj][m][1] * s;
                    u32x4 w; w.x = cvt_pk_bf16(v0[0], v0[1]); w.y = cvt_pk_bf16(v0[2], v0[3]); w.z = cvt_pk_bf16(v1[0], v1[1]); w.w = cvt_pk_bf16(v1[2], v1[3]);
                    *(u32x4*)(rowp + bj * HALF) = w; } }
    }
};
struct EpiRes {
    static constexpr bool PERM = true, AFTER_DRAIN = false;
    const float* base; float* out; bf16_t* outb; int ldc; float* ssq;
    __device__ __forceinline__ void operator()(const f32x4 (&acc)[2][2][4][2], const Unit& u, int wr, int wc, int fr, int fq) const {
        const int row0 = u.pm * BM + wr * 64 + fr, col0 = u.pn * BM + wc * 32 + 8 * fq;
#pragma unroll
        for (int ai = 0; ai < 2; ++ai)
#pragma unroll
            for (int m = 0; m < 4; ++m) { const int row = row0 + ai * HALF + m * 16; const size_t off = (size_t)row * ldc + col0; float s = 0.f;
#pragma unroll
                for (int bj = 0; bj < 2; ++bj) { const f32x4 b0 = *(const f32x4*)(base + off + bj * HALF), b1 = *(const f32x4*)(base + off + bj * HALF + 4);
                    const f32x4 v0 = acc[ai][bj][m][0] + b0, v1 = acc[ai][bj][m][1] + b1;
                    *(f32x4*)(out + off + bj * HALF) = v0; *(f32x4*)(out + off + bj * HALF + 4) = v1;
                    if (outb) { u32x4 w; w.x = cvt_pk_bf16(v0[0], v0[1]); w.y = cvt_pk_bf16(v0[2], v0[3]); w.z = cvt_pk_bf16(v1[0], v1[1]); w.w = cvt_pk_bf16(v1[2], v1[3]); *(u32x4*)(outb + off + bj * HALF) = w; }
                    s += sq4(v0) + sq4(v1); }
                s += __shfl_xor(s, 16); s += __shfl_xor(s, 32);
                if (fq == 0) ssq[(size_t)row * 32 + u.pn * 4 + wc] = s; }
    }
};
struct EpiSwiGLU {
    static constexpr bool PERM = true, AFTER_DRAIN = false;
    bf16_t* ff; int ldc; const float* ssq; float inv_n;
    __device__ __forceinline__ void operator()(const f32x4 (&acc)[2][2][4][2], const Unit& u, int wr, int wc, int fr, int fq) const {
        const int row0 = u.pm * BM + wr * 64 + fr, col0 = u.pn * HALF + wc * 32 + 8 * fq;
#pragma unroll
        for (int ai = 0; ai < 2; ++ai)
#pragma unroll
            for (int m = 0; m < 4; ++m) { const int row = row0 + ai * HALF + m * 16;
                const f32x4* sp = (const f32x4*)(ssq + (size_t)row * 32 + fq * 8); float s = sum4(sp[0]) + sum4(sp[1]);
                s += __shfl_xor(s, 16); s += __shfl_xor(s, 32);
                const float rs = 1.0f / sqrtf(s * inv_n + RMS_EPS);
                float f[8];
#pragma unroll
                for (int n = 0; n < 2; ++n)
#pragma unroll
                    for (int i = 0; i < 4; ++i) { const float g = acc[ai][0][m][n][i] * rs, up = acc[ai][1][m][n][i] * rs;
                        f[4 * n + i] = g * __builtin_amdgcn_rcpf(1.0f + __builtin_amdgcn_exp2f(-1.4426950408889634f * g)) * up; }
                u32x4 w; w.x = cvt_pk_bf16(f[0], f[1]); w.y = cvt_pk_bf16(f[2], f[3]); w.z = cvt_pk_bf16(f[4], f[5]); w.w = cvt_pk_bf16(f[6], f[7]);
                *(u32x4*)(ff + (size_t)row * ldc + col0) = w; }
    }
};

template <class Epi, class Sched, bool ALIGN_EPI = false, bool SP2 = false>
__device__ __forceinline__ void gemm_phase(PG8_LAS unsigned char* lds, const Gemm g, const Sched& S, const Epi& E) {
    const int tid = threadIdx.x, wid = __builtin_amdgcn_readfirstlane(tid >> 6), lane = tid & 63, wr = wid >> 2, wc = wid & 3, fr = lane & 15, fq = lane >> 4;
    const int K = g.K, nt = K / BK;
    unsigned voffA[2], voffB[2];
#pragma unroll
    for (int i = 0; i < 2; ++i) { int R, C; stage_rc(tid * 16 + i * 8192, R, C); const int Rb = Epi::PERM ? ((R & ~31) + perm32(R & 31)) : R;
        voffA[i] = (unsigned)(R * K + C) * 2u; voffB[i] = (unsigned)(Rb * K + C) * 2u; }
    const size_t kstep = (size_t)(BK * 2);
    const size_t hstep = (size_t)HALF * K * 2;
    const size_t tstep = 2 * hstep;
    const unsigned ldsw = (unsigned)wid * 1024u;
    const int aoff = lds_byte(wr * 64 + fr, fq * 8), boff = lds_byte(wc * 32 + fr, fq * 8);
#define PG8_SA(b, h) (((b) * 2 + (h)) * HTB)
#define PG8_SB(b, h) ((4 + (b) * 2 + (h)) * HTB)
#define PG8_STAGE(bufoff, gbase, voff) do { _Pragma("unroll") for (int _i = 0; _i < 2; ++_i) \
        __builtin_amdgcn_global_load_lds((const unsigned*)((const char*)(gbase) + (voff)[_i]), (PG8_LAS unsigned*)(lds + (bufoff) + ldsw + _i * 8192), 16, 0, 0); } while (0)
#define PG8_LDA(dst, b, h) do { _Pragma("unroll") for (int m = 0; m < 4; ++m) _Pragma("unroll") for (int k = 0; k < 2; ++k) dst[m][k] = *(const PG8_LAS bf16x8*)(lds + PG8_SA(b, h) + aoff + m * 2048 + k * 1024); } while (0)
#define PG8_LDB(dst, b, h) do { _Pragma("unroll") for (int n = 0; n < 2; ++n) _Pragma("unroll") for (int k = 0; k < 2; ++k) dst[n][k] = *(const PG8_LAS bf16x8*)(lds + PG8_SB(b, h) + boff + n * 2048 + k * 1024); } while (0)
#define PG8_MMA(ai, bj, At, Bt) do { __builtin_amdgcn_s_setprio(1); _Pragma("unroll") for (int m = 0; m < 4; ++m) _Pragma("unroll") for (int n = 0; n < 2; ++n) _Pragma("unroll") for (int k = 0; k < 2; ++k) \
        acc[ai][bj][m][n] = __builtin_amdgcn_mfma_f32_16x16x32_bf16(Bt[n][k], At[m][k], acc[ai][bj][m][n], 0, 0, 0); __builtin_amdgcn_s_setprio(0); } while (0)
#define PG8_WAIT_V(n) asm volatile("s_waitcnt vmcnt(" #n ")" ::: "memory")
#define PG8_WAIT_L(n) asm volatile("s_waitcnt lgkmcnt(" #n ")" ::: "memory")
#define PG8_BAR __builtin_amdgcn_s_barrier()
#define PG8_SCHED __builtin_amdgcn_sched_barrier(0)
    Unit cur, nxt; int ui = 0;
    if (!S.next(0, cur)) return;
    f32x4 acc[2][2][4][2];
#pragma unroll
    for (int a = 0; a < 2; ++a)
#pragma unroll
        for (int b = 0; b < 2; ++b)
#pragma unroll
            for (int m = 0; m < 4; ++m)
#pragma unroll
                for (int n = 0; n < 2; ++n) acc[a][b][m][n] = (f32x4){0.f, 0.f, 0.f, 0.f};
    bf16x8 At[4][2], B0[2][2], B1[2][2];
    const char* cA = (const char*)g.A + (size_t)cur.pm * tstep; const char* cB = (const char*)g.Bt + (size_t)cur.pn * tstep;
    S.a_ready(cur);
    if constexpr (SP2) {
        PG8_STAGE(PG8_SB(0, 0), cB, voffB); PG8_STAGE(PG8_SB(0, 1), cB + hstep, voffB); PG8_STAGE(PG8_SA(0, 0), cA, voffA); PG8_STAGE(PG8_SA(0, 1), cA + hstep, voffA);
        if (wr == 1) PG8_BAR;
        PG8_WAIT_V(2); PG8_BAR;
        PG8_STAGE(PG8_SB(1, 0), cB + kstep, voffB); PG8_STAGE(PG8_SA(1, 0), cA + kstep, voffA); PG8_STAGE(PG8_SB(1, 1), cB + hstep + kstep, voffB);
        PG8_WAIT_V(6); PG8_BAR;
    } else {
        PG8_STAGE(PG8_SB(0, 0), cB, voffB); PG8_STAGE(PG8_SA(0, 0), cA, voffA); PG8_STAGE(PG8_SB(0, 1), cB + hstep, voffB); PG8_STAGE(PG8_SA(0, 1), cA + hstep, voffA);
        if (wr == 1) PG8_BAR;
        PG8_WAIT_V(4); PG8_BAR;
        PG8_STAGE(PG8_SB(1, 0), cB + kstep, voffB); PG8_STAGE(PG8_SA(1, 0), cA + kstep, voffA); PG8_STAGE(PG8_SB(1, 1), cB + hstep + kstep, voffB);
        PG8_WAIT_V(6); PG8_BAR;
    }
    for (;;) {
        const bool has_next = S.next(ui + 1, nxt);
        const char* nA = has_next ? (const char*)g.A + (size_t)nxt.pm * tstep : cA; const char* nB = has_next ? (const char*)g.Bt + (size_t)nxt.pn * tstep : cB;
        for (int t = 0; t < nt; t += 2) {
            const bool last = (t == nt - 2);
            const char* a1 = cA + (size_t)(t + 1) * kstep;
            const char* a2 = last ? nA : cA + (size_t)(t + 2) * kstep; const char* b2 = last ? nB : cB + (size_t)(t + 2) * kstep;
            const char* a3 = a2 + kstep; const char* b3 = b2 + kstep;
            if (last && has_next) S.a_ready(nxt);
            if constexpr (SP2) {
            PG8_LDB(B0, 0, 0); PG8_LDB(B1, 0, 1); PG8_SCHED; PG8_LDA(At, 0, 0); PG8_STAGE(PG8_SA(1, 1), a1 + hstep, voffA);
            PG8_WAIT_V(8); PG8_WAIT_L(0); PG8_BAR; PG8_MMA(0, 0, At, B0); PG8_MMA(0, 1, At, B1); PG8_BAR; PG8_SCHED;
            PG8_LDA(At, 0, 1); PG8_STAGE(PG8_SB(0, 0), b2, voffB); PG8_STAGE(PG8_SB(0, 1), b2 + hstep, voffB); PG8_STAGE(PG8_SA(0, 0), a2, voffA);
            PG8_WAIT_V(8); PG8_WAIT_L(0); PG8_BAR; PG8_MMA(1, 0, At, B0); PG8_MMA(1, 1, At, B1); PG8_BAR; PG8_SCHED;
            PG8_LDB(B0, 1, 0); PG8_LDB(B1, 1, 1); PG8_SCHED; PG8_LDA(At, 1, 0); PG8_STAGE(PG8_SA(0, 1), a2 + hstep, voffA);
            PG8_WAIT_V(8); PG8_WAIT_L(0); PG8_BAR; PG8_MMA(0, 0, At, B0); PG8_MMA(0, 1, At, B1); PG8_BAR; PG8_SCHED;
            PG8_LDA(At, 1, 1); PG8_STAGE(PG8_SB(1, 0), b3, voffB); PG8_STAGE(PG8_SB(1, 1), b3 + hstep, voffB); PG8_STAGE(PG8_SA(1, 0), a3, voffA);
            PG8_WAIT_V(8); PG8_WAIT_L(0); PG8_BAR; PG8_MMA(1, 0, At, B0); PG8_MMA(1, 1, At, B1); PG8_BAR; PG8_SCHED;
            } else {
            PG8_LDB(B0, 0, 0); PG8_SCHED; PG8_LDA(At, 0, 0); PG8_STAGE(PG8_SA(1, 1), a1 + hstep, voffA);
            PG8_WAIT_L(8); PG8_BAR; PG8_WAIT_L(0); PG8_MMA(0, 0, At, B0); PG8_BAR; PG8_SCHED;
            PG8_LDB(B1, 0, 1); PG8_STAGE(PG8_SB(0, 0), b2, voffB);
            PG8_BAR; PG8_WAIT_L(0); PG8_MMA(0, 1, At, B1); PG8_BAR;
            PG8_LDA(At, 0, 1); PG8_STAGE(PG8_SA(0, 0), a2, voffA);
            PG8_BAR; PG8_WAIT_L(0); PG8_MMA(1, 0, At, B0); PG8_BAR; PG8_SCHED;
            PG8_STAGE(PG8_SB(0, 1), b2 + hstep, voffB);
            PG8_WAIT_V(6); PG8_BAR; PG8_MMA(1, 1, At, B1); PG8_BAR;
            PG8_LDB(B0, 1, 0); PG8_SCHED; PG8_LDA(At, 1, 0); PG8_STAGE(PG8_SA(0, 1), a2 + hstep, voffA);
            PG8_WAIT_L(8); PG8_BAR; PG8_WAIT_L(0); PG8_MMA(0, 0, At, B0); PG8_BAR; PG8_SCHED;
            PG8_LDB(B1, 1, 1); PG8_STAGE(PG8_SB(1, 0), b3, voffB);
            PG8_BAR; PG8_WAIT_L(0); PG8_MMA(0, 1, At, B1); PG8_BAR;
            PG8_LDA(At, 1, 1); PG8_STAGE(PG8_SA(1, 0), a3, voffA);
            PG8_BAR; PG8_WAIT_L(0); PG8_MMA(1, 0, At, B0); PG8_BAR; PG8_SCHED;
            PG8_STAGE(PG8_SB(1, 1), b3 + hstep, voffB);
            PG8_WAIT_V(6); PG8_BAR; PG8_MMA(1, 1, At, B1); PG8_BAR;
            }
        }
        if constexpr (ALIGN_EPI) { if (wr == 0) PG8_BAR; }
        if constexpr (!Epi::AFTER_DRAIN) { E(acc, cur, wr, wc, fr, fq); S.done(cur); }
        if (!has_next) break;
#pragma unroll
        for (int a = 0; a < 2; ++a)
#pragma unroll
            for (int b = 0; b < 2; ++b)
#pragma unroll
                for (int m = 0; m < 4; ++m)
#pragma unroll
                    for (int n = 0; n < 2; ++n) acc[a][b][m][n] = (f32x4){0.f, 0.f, 0.f, 0.f};
        cur = nxt; cA = nA; cB = nB; ++ui;
        if constexpr (ALIGN_EPI) { if (wr == 1) PG8_BAR; }
    }
    PG8_WAIT_V(0);
    if constexpr (!ALIGN_EPI) { if (wr == 0) PG8_BAR; }
    PG8_BAR;
    if constexpr (Epi::AFTER_DRAIN) { E.fused(acc, cur, wr, wc, fr, fq, lds, wid, lane); S.done(cur); }
#undef PG8_SA
#undef PG8_SB
#undef PG8_STAGE
#undef PG8_LDA
#undef PG8_LDB
#undef PG8_MMA
#undef PG8_WAIT_V
#undef PG8_WAIT_L
#undef PG8_BAR
#undef PG8_SCHED
}
}

#ifndef GLA_OPT
#define GLA_OPT 1
#endif
#ifndef ATT_OPT
#define ATT_OPT 1
#endif
constexpr int NWAVES = 8, NTHREADS = NWAVES * 64;
constexpr int N_LAUNCHES = MK_N_LAUNCHES;
constexpr int N_PHASES = 9;
constexpr int BATCH = 8, SEQ = 2048, D = 2048, M = BATCH * SEQ;
constexpr int HD = 64, NQH = 32, NKVH = 4, GQA = 8, WIN = 128;
constexpr int GH = 4, GDK = 256, GDV = 512, GRANK = 16, GCHUNK = 64;
constexpr int FF = 5632;
constexpr int DIN = 12816;
constexpr int PW = 12800;
constexpr int NP1 = 13056;
constexpr int C_AQ = 0, C_AK = 2048, C_AV = 2304, C_GQ = 2560, C_GK = 3584, C_GV = 4608, C_GR = 6656, C_GA = 8704, C_GB = 10752;
constexpr int SRC_GLR = 6656;
constexpr float RMS_EPS = 1e-6f;

constexpr size_t MiB = 1u << 20;
constexpr size_t WS_CTL = 0, CTL_ZERO_BYTES = 64 * 1024;
constexpr size_t WS_RSTD1 = 1 * MiB;
constexpr size_t WS_GLR = 2 * MiB;
constexpr size_t WS_DEC = 3 * MiB;
constexpr size_t WS_SSQG = 4 * MiB;
constexpr size_t WS_SSQ2 = 6 * MiB;
constexpr size_t WS_SSQ3 = 8 * MiB;
constexpr size_t WS_WOUT = 10 * MiB;
constexpr size_t WS_WDOWN = 18 * MiB;
constexpr size_t WS_WIN = 40 * MiB;
constexpr size_t WS_PROJ = 92 * MiB;
constexpr size_t WS_H1 = WS_PROJ;
constexpr size_t WS_H1B = WS_PROJ + 128 * MiB;
constexpr size_t WS_FF = WS_PROJ + 192 * MiB;
constexpr size_t WS_END = 492 * MiB;
static_assert(WS_WIN + (size_t)NP1 * D * 2 <= WS_PROJ && WS_PROJ + (size_t)M * PW * 2 <= WS_END && WS_FF + (size_t)M * FF * 2 <= WS_END && WS_WDOWN + (size_t)D * FF * 2 <= WS_WIN, "ws map");
constexpr size_t OUT_XB = 0;
constexpr size_t OUT_WGU = 64 * MiB;
constexpr int CW_BAR = 1024;

constexpr int RING_BYTES = 131072, LDSCTL_OFF = RING_BYTES, MISC_OFF = LDSCTL_OFF + 320, LDS_BYTES = 147456;

#define GAS __attribute__((address_space(1)))
#define LAS __attribute__((address_space(3)))
typedef unsigned short bf16;
typedef unsigned v4u __attribute__((ext_vector_type(4)));
typedef unsigned v2u __attribute__((ext_vector_type(2)));
typedef float f32x4 __attribute__((ext_vector_type(4)));
typedef GAS unsigned gu32;
#define LDS_WAIT() asm volatile("s_waitcnt lgkmcnt(0)" ::: "memory")
#define VM_WAIT() asm volatile("s_waitcnt vmcnt(0)" ::: "memory")
__device__ __forceinline__ unsigned f2bf(float f) { unsigned u = __builtin_bit_cast(unsigned, f); return (u + 0x7fffu + ((u >> 16) & 1u)) >> 16; }
__device__ __forceinline__ unsigned pk2(float lo, float hi) { return f2bf(lo) | (f2bf(hi) << 16); }
__device__ __forceinline__ float bf2f(unsigned short b) { return __builtin_bit_cast(float, (unsigned)b << 16); }
__device__ __forceinline__ float bflo(unsigned w) { return __builtin_bit_cast(float, w << 16); }
__device__ __forceinline__ float bfhi(unsigned w) { return __builtin_bit_cast(float, w & 0xffff0000u); }
__device__ __forceinline__ float sigmoidf_(float x) { return 1.0f / (1.0f + __expf(-x)); }

#define XB_TMO      128
#define XB_XCNT(j)  (256  + 64 * (j))
#define XB_XSUB(j)  (1280 + 64 * (j))
#define XB_XGEN(j)  (2304 + 64 * (j))
#define XB_TOP      3328
#define XB_TOPGEN   3392
#define XCD_BAR_WORDS 3456
#define XB_SPIN_CAP (1u << 22)
static_assert((CW_BAR + XCD_BAR_WORDS) * 4 <= (int)CTL_ZERO_BYTES, "barrier words inside the memset region");

__device__ __forceinline__ unsigned xb_ld(unsigned* p)              { return __hip_atomic_load(p, __ATOMIC_RELAXED, __HIP_MEMORY_SCOPE_AGENT); }
__device__ __forceinline__ unsigned xb_add(unsigned* p, unsigned v) { return __hip_atomic_fetch_add(p, v, __ATOMIC_RELAXED, __HIP_MEMORY_SCOPE_AGENT); }
__device__ __forceinline__ unsigned xb_xcc_id() { return (unsigned)__builtin_amdgcn_s_getreg((3 << 11) | 20) & 0xFu; }
#define XB_SPIN(cond, bar) do { unsigned _sp = 0; while (cond) { __builtin_amdgcn_s_sleep(1); \
    if ((++_sp & 255u) == 0u) { if (xb_ld(&(bar)[XB_TMO])) break; if (_sp > XB_SPIN_CAP) { atomicAdd(&(bar)[XB_TMO], 1u); break; } } } } while (0)

struct XcdBarrier { unsigned* bar; unsigned x; volatile LAS unsigned* st; };

__device__ __forceinline__ XcdBarrier xcd_barrier_post(unsigned* bar, volatile LAS unsigned* st) {
    XcdBarrier b; b.bar = bar; b.x = xb_xcc_id(); b.st = st;
    if (threadIdx.x == 0) (void)xb_add(&bar[XB_XCNT(b.x)], 1u);
    return b;
}
__device__ __forceinline__ void xcd_barrier_complete(unsigned* bar, unsigned x, unsigned& nloc, unsigned& nx) {
    const unsigned G = gridDim.x * gridDim.y * gridDim.z;
    unsigned sum, cnt, mine, sp = 0u;
    for (;;) {
        sum = 0u; cnt = 0u; mine = 0u;
#pragma unroll
        for (unsigned j = 0; j < 16; ++j) { const unsigned c = xb_ld(&bar[XB_XCNT(j)]); sum += c; cnt += (c > 0u) ? 1u : 0u; mine = (j == x) ? c : mine; }
        if (sum == G) break;
        __builtin_amdgcn_s_sleep(1);
        if ((++sp & 255u) == 0u) { if (xb_ld(&bar[XB_TMO])) break; if (sp > XB_SPIN_CAP) { atomicAdd(&bar[XB_TMO], 1u); break; } }
    }
    nloc = mine > 0u ? mine : 1u; nx = cnt > 0u ? cnt : 1u;
}
__device__ __forceinline__ void xcd_barrier(const XcdBarrier& b) {
    asm volatile("s_waitcnt vmcnt(0)" ::: "memory");
    __syncthreads();
    if (threadIdx.x == 0) {
        unsigned* bar = b.bar;
        __builtin_amdgcn_s_waitcnt(0);
        unsigned nloc = b.st[0], nx = b.st[1];
        if (nloc == 0u) { xcd_barrier_complete(bar, b.x, nloc, nx); b.st[0] = nloc; b.st[1] = nx; }
        const unsigned old = xb_add(&bar[XB_XSUB(b.x)], 1u);
        const unsigned gen = old / nloc;
        if (old + 1u == (gen + 1u) * nloc) {
            __builtin_amdgcn_fence(__ATOMIC_RELEASE, "agent");
            asm volatile("s_waitcnt vmcnt(0)" ::: "memory");
            const unsigned og = xb_add(&bar[XB_TOP], 1u);
            const unsigned tg = og / nx;
            if (og + 1u == (tg + 1u) * nx) xb_add(&bar[XB_TOPGEN], 1u);
            else XB_SPIN(xb_ld(&bar[XB_TOPGEN]) == tg, bar);
            __builtin_amdgcn_fence(__ATOMIC_ACQUIRE, "agent");
            xb_add(&bar[XB_XGEN(b.x)], 1u);
            asm volatile("s_waitcnt vmcnt(0)" ::: "memory");
        } else {
            XB_SPIN(xb_ld(&bar[XB_XGEN(b.x)]) == gen, bar);
            __builtin_amdgcn_fence(__ATOMIC_ACQUIRE, "agent");
            asm volatile("s_waitcnt vmcnt(0)" ::: "memory");
        }
    }
    __syncthreads();
}

struct Frame {
    LAS unsigned char* lds;
    volatile LAS unsigned* MISC;
    gu32* ctl;
    int tid, lane, wave, vcu, G;
    const float *x, *norm1_w, *w_in, *gate_w2, *gate_b, *sinks, *gnorm_w, *w_out, *norm2_w, *w_gate, *w_up, *w_down, *fnorm_w;
    float* out;
    unsigned char* ws;
    bf16 *Win_t, *Wout_t, *Wgu_t, *Wdown_t, *XB, *PROJ, *MERGED, *H1B, *FFB;
    float *RSTD1, *GLR, *DEC, *SSQG, *SSQ2, *SSQ3, *H1;
};

__device__ __forceinline__ float wave_sum(float v) {
#pragma unroll
    for (int o = 1; o < 64; o <<= 1) v += __shfl_xor(v, o);
    return v;
}

__device__ __forceinline__ void p0_transpose_item(const float* W, int ldw, int srccol, const float* kscale, int K, bf16* WTrow0, LAS float* scr, int k0, int lane) {
#pragma unroll 8
    for (int i = 0; i < 32; ++i) { const int kk = 2 * i + (lane >> 5); float v = 0.f;
        if (srccol >= 0) v = W[(size_t)(k0 + kk) * ldw + srccol];
        if (kscale) v *= kscale[k0 + kk];
        scr[kk * 33 + (lane & 31)] = v; }
    LDS_WAIT(); asm volatile("" ::: "memory");
    const int c = lane & 7;
#pragma unroll
    for (int j = 0; j < 4; ++j) { const int n = (lane >> 3) + 8 * j; const LAS float* s = scr + (8 * c) * 33 + n;
        v4u o; o.x = pk2(s[0 * 33], s[1 * 33]); o.y = pk2(s[2 * 33], s[3 * 33]); o.z = pk2(s[4 * 33], s[5 * 33]); o.w = pk2(s[6 * 33], s[7 * 33]);
        *(GAS v4u*)(WTrow0 + (size_t)n * K + k0 + 8 * c) = o; }
    LDS_WAIT(); asm volatile("" ::: "memory");
}
__device__ __forceinline__ void p0_prologue(Frame& F) {
    LAS float* scr = (LAS float*)(F.lds + F.wave * 16384);
    const int gw = F.vcu * NWAVES + F.wave, NGW = F.G * NWAVES;
    constexpr int I_IN = (D / 64) * (NP1 / 32), I_OUT = (D / 64) * (D / 32), I_GU = (D / 64) * (2 * FF / 32), I_DN = (FF / 64) * (D / 32);
    constexpr int NITEMS = I_IN + I_OUT + I_GU + I_DN;
    const int l31 = F.lane & 31;
    for (int it = gw; it < NITEMS; it += NGW) {
        int r = it;
        if (r < I_IN) { const int nblk = NP1 / 32, kb = r / nblk, nb = r % nblk, n = nb * 32 + l31;
            const int sc = n < SRC_GLR ? n : (n < PW ? n + GRANK : (n < PW + GRANK ? SRC_GLR + (n - PW) : -1));
            p0_transpose_item(F.w_in, DIN, sc, F.norm1_w, D, F.Win_t + (size_t)(nb * 32) * D, scr, kb * 64, F.lane); continue; }
        r -= I_IN;
        if (r < I_OUT) { const int nblk = D / 32, kb = r / nblk, nb = r % nblk;
            p0_transpose_item(F.w_out, D, nb * 32 + l31, nullptr, D, F.Wout_t + (size_t)(nb * 32) * D, scr, kb * 64, F.lane); continue; }
        r -= I_OUT;
        if (r < I_GU) { const int nblk = 2 * FF / 32, kb = r / nblk, nb = r % nblk, n0 = nb * 32, pn = n0 >> 8, bj = (n0 >> 7) & 1, hl = (n0 & 127) + l31;
            p0_transpose_item(bj ? F.w_up : F.w_gate, FF, pn * 128 + hl, F.norm2_w, D, F.Wgu_t + (size_t)n0 * D, scr, kb * 64, F.lane); continue; }
        r -= I_GU;
        { const int nblk = D / 32, kb = r / nblk, nb = r % nblk;
            p0_transpose_item(F.w_down, D, nb * 32 + l31, nullptr, FF, F.Wdown_t + (size_t)(nb * 32) * FF, scr, kb * 64, F.lane); }
    }
    for (int m = gw; m < M; m += NGW) {
        const GAS f32x4* xr = (const GAS f32x4*)(F.x + (size_t)m * D) + F.lane;
        f32x4 v[8]; float s = 0.f;
#pragma unroll
        for (int j = 0; j < 8; ++j) { v[j] = xr[64 * j]; s += (v[j].x * v[j].x + v[j].y * v[j].y) + (v[j].z * v[j].z + v[j].w * v[j].w); }
        s = wave_sum(s);
        if (F.lane == 0) F.RSTD1[m] = 1.0f / sqrtf(s * (1.0f / D) + RMS_EPS);
        GAS v2u* o8 = (GAS v2u*)(F.XB + (size_t)m * D) + F.lane;
#pragma unroll
        for (int j = 0; j < 8; ++j) { v2u w; w.x = pk2(v[j].x, v[j].y); w.y = pk2(v[j].z, v[j].w); o8[64 * j] = w; }
    }
}

__device__ __forceinline__ void p2_gla_naive(Frame& F) {
    float* al = (float*)(F.lds);
    float* kk = al + 256;
    float* qq = kk + 256;
    float* vv = qq + 256;
    float* red = vv + 64;
    const int tid = F.tid, lane = F.lane, wave = F.wave;
    const int vl = tid >> 3, dq = tid & 7;
    for (int unit = blockIdx.x; unit < BATCH * GH * 8; unit += gridDim.x) {
        const int b = unit >> 5, h = (unit >> 3) & 3, vs = unit & 7;
        float S[32];
#pragma unroll
        for (int d = 0; d < 32; ++d) S[d] = 0.f;
        float w2r[16]; float bias = 0.f;
        const int dch = tid & 255;
#pragma unroll
        for (int r = 0; r < 16; ++r) w2r[r] = F.gate_w2[r * (GH * GDK) + h * GDK + dch];
        bias = F.gate_b[h * GDK + dch];
        for (int t = 0; t < SEQ; ++t) {
            const size_t row = (size_t)b * SEQ + t;
            const bf16* prow = F.PROJ + row * PW;
            if (tid < 256) {
                const f32x4* g4 = (const f32x4*)(F.GLR + row * 16);
                float logit = bias;
#pragma unroll
                for (int r4 = 0; r4 < 4; ++r4) { const f32x4 g = g4[r4]; logit += g[0] * w2r[4 * r4] + g[1] * w2r[4 * r4 + 1] + g[2] * w2r[4 * r4 + 2] + g[3] * w2r[4 * r4 + 3]; }
                const float ls = fminf(logit, 0.f) - log1pf(expf(-fabsf(logit)));
                al[tid] = expf(ls * (1.0f / 16.0f));
                qq[tid] = bf2f(prow[C_GQ + h * GDK + tid]) * (1.0f / 16.0f);
                kk[tid] = bf2f(prow[C_GK + h * GDK + tid]);
            } else if (tid < 320) {
                vv[tid - 256] = bf2f(prow[C_GV + h * GDV + vs * 64 + (tid - 256)]);
            }
            __syncthreads();
            const float v = vv[vl]; float acc = 0.f;
#pragma unroll
            for (int d = 0; d < 32; ++d) { const int dd = dq * 32 + d; S[d] = al[dd] * S[d] + kk[dd] * v; acc += qq[dd] * S[d]; }
            acc += __shfl_xor(acc, 1); acc += __shfl_xor(acc, 2); acc += __shfl_xor(acc, 4);
            const float ob = bf2f((unsigned short)f2bf(acc));
            float o2 = ob * ob;
            o2 += __shfl_xor(o2, 8); o2 += __shfl_xor(o2, 16); o2 += __shfl_xor(o2, 32);
            if (lane == 0) red[wave] = o2;
            if (dq == 0) ((bf16*)prow)[C_GV + h * GDV + vs * 64 + vl] = (bf16)f2bf(acc);
            __syncthreads();
            if (tid == 0) { float s = 0.f;
#pragma unroll
                for (int w = 0; w < 8; ++w) s += red[w];
                F.SSQG[row * 32 + h * 8 + vs] = s; }
        }
        __syncthreads();
    }
}

__device__ __forceinline__ void p3_attn_naive(Frame& F) {
    constexpr int KST = 66;
    bf16* Ks = (bf16*)F.lds;
    bf16* Vs = Ks + 256 * KST;
    const int tid = F.tid;
    for (int unit = blockIdx.x; unit < BATCH * 16 * NKVH; unit += gridDim.x) {
        const int b = unit >> 6, nb = (unit >> 2) & 15, kvh = unit & 3;
        __syncthreads();
        for (int c = tid; c < 256 * 32; c += NTHREADS) {
            const int j = c >> 5, w = c & 31; const int tok = (nb - 1) * WIN + j;
            unsigned kw = 0u, vw = 0u;
            if (tok >= 0) { const bf16* prow = F.PROJ + ((size_t)b * SEQ + tok) * PW;
                kw = *(const unsigned*)(prow + C_AK + kvh * HD + 2 * w); vw = *(const unsigned*)(prow + C_AV + kvh * HD + 2 * w); }
            *(unsigned*)(Ks + j * KST + 2 * w) = kw; *(unsigned*)(Vs + j * KST + 2 * w) = vw;
        }
        __syncthreads();
        const int g = tid >> 6, hq = kvh * GQA + g;
        const float sink = F.sinks[hq];
        for (int rep = 0; rep < 2; ++rep) {
            const int i = (tid & 63) + 64 * rep;
            const size_t row = (size_t)b * SEQ + nb * WIN + i;
            const bf16* prow = F.PROJ + row * PW;
            float q[64], o[64];
#pragma unroll
            for (int d2 = 0; d2 < 32; ++d2) { const unsigned w = *(const unsigned*)(prow + C_AQ + hq * HD + 2 * d2); q[2 * d2] = bflo(w) * 0.125f; q[2 * d2 + 1] = bfhi(w) * 0.125f; o[2 * d2] = 0.f; o[2 * d2 + 1] = 0.f; }
            float mx = sink, l = 1.0f;
            for (int jj = 1; jj <= WIN; ++jj) {
                const int ki = i + jj;
                if (nb == 0 && ki < WIN) continue;
                const unsigned* kr = (const unsigned*)(Ks + ki * KST);
                float s = 0.f;
#pragma unroll
                for (int d2 = 0; d2 < 32; ++d2) { const unsigned w = kr[d2]; s += q[2 * d2] * bflo(w) + q[2 * d2 + 1] * bfhi(w); }
                const float mn = fmaxf(mx, s), sc = __expf(mx - mn), p = __expf(s - mn);
                l = l * sc + p; mx = mn;
                const unsigned* vr = (const unsigned*)(Vs + ki * KST);
#pragma unroll
                for (int d2 = 0; d2 < 32; ++d2) { const unsigned w = vr[d2]; o[2 * d2] = o[2 * d2] * sc + p * bflo(w); o[2 * d2 + 1] = o[2 * d2 + 1] * sc + p * bfhi(w); }
            }
            const float il = 1.0f / l;
            float sg = 0.f;
#pragma unroll
            for (int s8 = 0; s8 < 8; ++s8) sg += F.SSQG[row * 32 + kvh * 8 + s8];
            const float rg = 1.0f / sqrtf(sg * (1.0f / GDV) + RMS_EPS);
            const int cb = hq * HD;
            bf16* mrow = F.MERGED + row * D + cb;
#pragma unroll
            for (int d2 = 0; d2 < 32; ++d2) {
                const unsigned wa = *(const unsigned*)(prow + C_GA + cb + 2 * d2), wb = *(const unsigned*)(prow + C_GB + cb + 2 * d2);
                const unsigned wr_ = *(const unsigned*)(prow + C_GR + cb + 2 * d2), wg = *(const unsigned*)(prow + C_GV + cb + 2 * d2);
                const float gr0 = bflo(wr_), gr1 = bfhi(wr_);
                const float gl0 = bflo(wg) * rg * F.gnorm_w[g * HD + 2 * d2] * (gr0 * sigmoidf_(gr0));
                const float gl1 = bfhi(wg) * rg * F.gnorm_w[g * HD + 2 * d2 + 1] * (gr1 * sigmoidf_(gr1));
                const float m0 = sigmoidf_(bflo(wa)) * (o[2 * d2] * il) + sigmoidf_(bflo(wb)) * gl0;
                const float m1 = sigmoidf_(bfhi(wa)) * (o[2 * d2 + 1] * il) + sigmoidf_(bfhi(wb)) * gl1;
                *(unsigned*)(mrow + 2 * d2) = pk2(m0, m1);
            }
        }
    }
    __syncthreads();
}

typedef short bf16x8_t __attribute__((ext_vector_type(8)));
typedef short s16x4_t __attribute__((ext_vector_type(4)));
typedef float f32x16 __attribute__((ext_vector_type(16)));
__device__ __forceinline__ unsigned cvtpk(float lo, float hi) { typedef float f2 __attribute__((ext_vector_type(2))); typedef __bf16 b2 __attribute__((ext_vector_type(2)));
    f2 v = {lo, hi}; b2 b = __builtin_convertvector(v, b2); return __builtin_bit_cast(unsigned, b); }
__device__ __forceinline__ s16x4_t tr_read(LAS const unsigned char* p) { return __builtin_bit_cast(s16x4_t, __builtin_amdgcn_ds_read_tr16_b64_v4i16((LAS s16x4_t*)p)); }
__device__ __forceinline__ bf16x8_t cat8(s16x4_t lo, s16x4_t hi) { return __builtin_shufflevector(lo, hi, 0, 1, 2, 3, 4, 5, 6, 7); }
#define MFMA16(a, b, c) __builtin_amdgcn_mfma_f32_16x16x32_bf16((a), (b), (c), 0, 0, 0)
#define MFMA32(a, b, c) __builtin_amdgcn_mfma_f32_32x32x16_bf16((a), (b), (c), 0, 0, 0)

__device__ __forceinline__ void p2a_gla_prep(Frame& F) {
    LAS float* glr_s = (LAS float*)F.lds;
    LAS float* tot = glr_s + 64 * 16;
    const int tid = F.tid, cp = tid & 127, tg = tid >> 7, d0 = 2 * cp;
    for (int unit = F.vcu; unit < BATCH * 32 * GH; unit += F.G) {
        const int b = unit >> 7, c = (unit >> 2) & 31, h = unit & 3;
        const size_t row0 = (size_t)b * SEQ + c * GCHUNK;
        __syncthreads();
        if (tid < 256) ((LAS f32x4*)glr_s)[tid] = ((const f32x4*)(F.GLR + row0 * 16))[tid];
        float wa[16], wb[16];
#pragma unroll
        for (int r = 0; r < 16; ++r) { const float2 w = *(const float2*)(F.gate_w2 + r * (GH * GDK) + h * GDK + d0); wa[r] = w.x; wb[r] = w.y; }
        const float2 bb = *(const float2*)(F.gate_b + h * GDK + d0);
        __syncthreads();
        float ga[16], gb[16]; float ca = 0.f, cb = 0.f;
#pragma unroll
        for (int i = 0; i < 16; ++i) {
            const LAS f32x4* g4 = (const LAS f32x4*)(glr_s + (16 * tg + i) * 16);
            float la = bb.x, lb = bb.y;
#pragma unroll
            for (int r4 = 0; r4 < 4; ++r4) { const f32x4 g = g4[r4];
                la += g[0] * wa[4 * r4] + g[1] * wa[4 * r4 + 1] + g[2] * wa[4 * r4 + 2] + g[3] * wa[4 * r4 + 3];
                lb += g[0] * wb[4 * r4] + g[1] * wb[4 * r4 + 1] + g[2] * wb[4 * r4 + 2] + g[3] * wb[4 * r4 + 3]; }
            const float sa = fminf(la, 0.f) - log1pf(__expf(-fabsf(la))), sb = fminf(lb, 0.f) - log1pf(__expf(-fabsf(lb)));
            ca += sa * (1.0f / 16.0f); cb += sb * (1.0f / 16.0f); ga[i] = ca; gb[i] = cb;
        }
        tot[tg * 256 + d0] = ca; tot[tg * 256 + d0 + 1] = cb;
        __syncthreads();
        float pa = 0.f, pb = 0.f;
#pragma unroll
        for (int t = 0; t < 3; ++t) if (t < tg) { pa += tot[t * 256 + d0]; pb += tot[t * 256 + d0 + 1]; }
        bf16* base = F.PROJ + (row0 + 16 * tg) * PW + h * GDK + d0;
#pragma unroll
        for (int i = 0; i < 16; ++i) {
            const float ea = __expf(pa + ga[i]), eb = __expf(pb + gb[i]);
            unsigned* qp = (unsigned*)(base + (size_t)i * PW + C_GQ); unsigned* kp = (unsigned*)(base + (size_t)i * PW + C_GK);
            const unsigned qw = *qp, kw = *kp;
            *qp = cvtpk(bflo(qw) * ea * (1.0f / 16.0f), bfhi(qw) * eb * (1.0f / 16.0f));
            *kp = cvtpk(bflo(kw) / ea, bfhi(kw) / eb);
        }
        if (tg == 3) { float2 dv; dv.x = __expf(pa + ca); dv.y = __expf(pb + cb); *(float2*)(F.DEC + (size_t)(b * 32 + c) * (GH * GDK) + h * GDK + d0) = dv; }
    }
    __syncthreads();
}

__device__ __forceinline__ void p2b_gla_main(Frame& F) {
    constexpr int QST = 528, VST = 144, AST = 144, OST = 272;
    constexpr int L_QD = 0, L_KI = 64 * QST, L_V = 2 * 64 * QST, L_ATT = L_V + 64 * VST, L_OP = L_ATT + 64 * AST, L_DEC = L_OP + 2 * 64 * OST, L_END = L_DEC + 1024;
    static_assert(L_END <= RING_BYTES, "gla lds");
    LAS unsigned char* lds = F.lds;
    const int tid = F.tid, lane = F.lane, w = F.wave, cw = w & 3, kh = w >> 2, c16 = lane & 15, g = lane >> 4, q4 = (lane & 15) >> 2, p4 = lane & 3;
    for (int i = tid; i < 64 * AST / 4; i += NTHREADS) ((LAS unsigned*)(lds + L_ATT))[i] = 0u;
    for (int unit = F.vcu; unit < BATCH * GH * 8; unit += F.G) {
        const int b = unit >> 5, h = (unit >> 3) & 3, vs = unit & 7;
        f32x4 S[8];
#pragma unroll
        for (int t = 0; t < 8; ++t) S[t] = (f32x4){0.f, 0.f, 0.f, 0.f};
        v4u pq[4], pk[4], pv; float pdec = 0.f;
        const bf16* gq0 = F.PROJ + (size_t)b * SEQ * PW + C_GQ + h * GDK;
        const bf16* gk0 = F.PROJ + (size_t)b * SEQ * PW + C_GK + h * GDK;
        bf16* gv0 = F.PROJ + (size_t)b * SEQ * PW + C_GV + h * GDV + vs * 64;
        const float* dec0 = F.DEC + (size_t)b * 32 * (GH * GDK) + h * GDK;
#define GLA_LOAD(c) do { const size_t r0_ = (size_t)(c) * GCHUNK; \
        _Pragma("unroll") for (int i_ = 0; i_ < 4; ++i_) { const int id_ = tid + NTHREADS * i_, row_ = id_ >> 5, ch_ = id_ & 31; \
            pq[i_] = *(const v4u*)(gq0 + (r0_ + row_) * PW + ch_ * 8); pk[i_] = *(const v4u*)(gk0 + (r0_ + row_) * PW + ch_ * 8); } \
        pv = *(const v4u*)(gv0 + (r0_ + (tid >> 3)) * PW + (tid & 7) * 8); \
        if (tid < 256) pdec = dec0[(size_t)(c) * (GH * GDK) + tid]; } while (0)
#define GLA_STORE() do { \
        _Pragma("unroll") for (int i_ = 0; i_ < 4; ++i_) { const int id_ = tid + NTHREADS * i_, row_ = id_ >> 5, ch_ = id_ & 31; \
            *(LAS v4u*)(lds + L_QD + row_ * QST + ch_ * 16) = pq[i_]; *(LAS v4u*)(lds + L_KI + row_ * QST + ch_ * 16) = pk[i_]; } \
        *(LAS v4u*)(lds + L_V + (tid >> 3) * VST + (tid & 7) * 16) = pv; \
        if (tid < 256) *(LAS float*)(lds + L_DEC + tid * 4) = pdec; } while (0)
        __syncthreads();
        GLA_LOAD(0); GLA_STORE();
        __syncthreads();
        for (int c = 0; c < SEQ / GCHUNK; ++c) {
            if (c + 1 < SEQ / GCHUNK) GLA_LOAD(c + 1);
#pragma unroll
            for (int tt = 0; tt < 2; ++tt) { const int tile = 2 * w + tt, it = tile >> 2, jt = tile & 3;
                if (jt <= it) {
                    f32x4 acc = {0.f, 0.f, 0.f, 0.f};
                    const LAS unsigned char* ap = lds + L_QD + (16 * it + c16) * QST + g * 16; const LAS unsigned char* bp = lds + L_KI + (16 * jt + c16) * QST + g * 16;
#pragma unroll
                    for (int s = 0; s < 8; ++s) { const bf16x8_t a = *(const LAS bf16x8_t*)(ap + s * 64), bb = *(const LAS bf16x8_t*)(bp + s * 64); acc = MFMA16(a, bb, acc); }
#pragma unroll
                    for (int r = 0; r < 4; ++r) { float v = acc[r]; if (it == jt && c16 > 4 * g + r) v = 0.f;
                        *(LAS unsigned short*)(lds + L_ATT + (16 * it + 4 * g + r) * AST + (16 * jt + c16) * 2) = (unsigned short)f2bf(v); }
                }
            }
            __syncthreads();
            bf16x8_t vf[2];
#pragma unroll
            for (int s = 0; s < 2; ++s) { const LAS unsigned char* vp = lds + L_V + (32 * s + 8 * g + q4) * VST + (16 * cw + 4 * p4) * 2; vf[s] = cat8(tr_read(vp), tr_read(vp + 4 * VST)); }
            bf16x8_t sb[4];
#pragma unroll
            for (int s = 0; s < 4; ++s) { v4u t; t.x = cvtpk(S[2 * s][0], S[2 * s][1]); t.y = cvtpk(S[2 * s][2], S[2 * s][3]); t.z = cvtpk(S[2 * s + 1][0], S[2 * s + 1][1]); t.w = cvtpk(S[2 * s + 1][2], S[2 * s + 1][3]); sb[s] = __builtin_bit_cast(bf16x8_t, t); }
#pragma unroll
            for (int it = 0; it < 4; ++it) {
                f32x4 oa = {0.f, 0.f, 0.f, 0.f};
                { const bf16x8_t a = *(const LAS bf16x8_t*)(lds + L_ATT + (16 * it + c16) * AST + (32 * kh + 8 * g) * 2); oa = MFMA16(a, kh ? vf[1] : vf[0], oa); }
                const LAS unsigned char* qp = lds + L_QD + (16 * it + c16) * QST + (128 * kh + 4 * g) * 2;
#pragma unroll
                for (int s = 0; s < 4; ++s) { const s16x4_t lo = *(const LAS s16x4_t*)(qp + s * 64), hi = *(const LAS s16x4_t*)(qp + s * 64 + 32); oa = MFMA16(cat8(lo, hi), sb[s], oa); }
#pragma unroll
                for (int r = 0; r < 4; ++r) *(LAS float*)(lds + L_OP + kh * 64 * OST + (16 * it + 4 * g + r) * OST + (16 * cw + c16) * 4) = oa[r];
            }
#pragma unroll
            for (int t = 0; t < 8; ++t) {
#pragma unroll
                for (int s = 0; s < 2; ++s) { const LAS unsigned char* kp = lds + L_KI + (32 * s + 8 * g + q4) * QST + (128 * kh + 16 * t + 4 * p4) * 2; S[t] = MFMA16(cat8(tr_read(kp), tr_read(kp + 4 * QST)), vf[s], S[t]); }
                const f32x4 dc = *(const LAS f32x4*)(lds + L_DEC + (128 * kh + 16 * t + 4 * g) * 4);
                S[t] = S[t] * dc;
            }
            __syncthreads();
            { const int row = tid >> 3, cg = tid & 7;
                const LAS f32x4* o0 = (const LAS f32x4*)(lds + L_OP + row * OST + cg * 32); const LAS f32x4* o1 = (const LAS f32x4*)(lds + L_OP + 64 * OST + row * OST + cg * 32);
                const f32x4 a = o0[0] + o1[0], bq = o0[1] + o1[1];
                v4u wv; wv.x = cvtpk(a[0], a[1]); wv.y = cvtpk(a[2], a[3]); wv.z = cvtpk(bq[0], bq[1]); wv.w = cvtpk(bq[2], bq[3]);
                const size_t grow = (size_t)c * GCHUNK + row;
                *(v4u*)(gv0 + grow * PW + cg * 8) = wv;
                float ss = (a[0] * a[0] + a[1] * a[1]) + (a[2] * a[2] + a[3] * a[3]) + (bq[0] * bq[0] + bq[1] * bq[1]) + (bq[2] * bq[2] + bq[3] * bq[3]);
                ss += __shfl_xor(ss, 1); ss += __shfl_xor(ss, 2); ss += __shfl_xor(ss, 4);
                if (cg == 0) F.SSQG[((size_t)b * SEQ + grow) * 32 + h * 8 + vs] = ss; }
            if (c + 1 < SEQ / GCHUNK) GLA_STORE();
            __syncthreads();
        }
#undef GLA_LOAD
#undef GLA_STORE
    }
}

__device__ __forceinline__ int crow(int r, int hi) { return (r & 3) + 8 * (r >> 2) + 4 * hi; }
__device__ __forceinline__ void p3_attn(Frame& F) {
    constexpr int KST = 144, VST = 192;
    constexpr int L_K = 0, L_V = 256 * KST, L_OST = L_V + 256 * VST, L_WSF = L_OST + 8 * 4096, L_END = L_WSF + 8 * 128;
    static_assert(L_END <= RING_BYTES, "attn lds");
    LAS unsigned char* lds = F.lds;
    const int tid = F.tid, lane = F.lane, w = F.wave, r32 = lane & 31, hi = lane >> 5, q4 = (lane & 15) >> 2, p4 = lane & 3, blk = (lane >> 4) & 1;
    constexpr float C2 = 0.125f * 1.4426950408889634f, LOG2E = 1.4426950408889634f, NEG = -1e30f;
    LAS unsigned char* ost = lds + L_OST + w * 4096;
    LAS float* wsf = (LAS float*)(lds + L_WSF + w * 128);
    for (int unit = F.vcu; unit < BATCH * 16 * NKVH; unit += F.G) {
        const int b = unit >> 6, nb = (unit >> 2) & 15, kvh = unit & 3;
        __syncthreads();
#pragma unroll
        for (int i = 0; i < 4; ++i) { const int id = tid + NTHREADS * i, row = id >> 3, ch = id & 7; const int tok = (nb - 1) * WIN + row;
            v4u kv = {0u, 0u, 0u, 0u}, vv = {0u, 0u, 0u, 0u};
            if (tok >= 0) { const bf16* prow = F.PROJ + ((size_t)b * SEQ + tok) * PW + kvh * HD + ch * 8; kv = *(const v4u*)(prow + C_AK); vv = *(const v4u*)(prow + C_AV); }
            *(LAS v4u*)(lds + L_K + row * KST + ch * 16) = kv; *(LAS v4u*)(lds + L_V + row * VST + ch * 16) = vv; }
        __syncthreads();
        const int hq = kvh * GQA + w;
        const float sink2 = F.sinks[hq] * LOG2E;
        float gw8[8];
        { const f32x4 g0 = *(const f32x4*)(F.gnorm_w + w * HD + (lane & 7) * 8), g1 = *(const f32x4*)(F.gnorm_w + w * HD + (lane & 7) * 8 + 4);
            gw8[0] = g0[0]; gw8[1] = g0[1]; gw8[2] = g0[2]; gw8[3] = g0[3]; gw8[4] = g1[0]; gw8[5] = g1[1]; gw8[6] = g1[2]; gw8[7] = g1[3]; }
        for (int qt = 0; qt < 4; ++qt) {
            const size_t rowq = (size_t)b * SEQ + nb * WIN + 32 * qt;
            bf16x8_t qf[4];
#pragma unroll
            for (int s = 0; s < 4; ++s) qf[s] = *(const bf16x8_t*)(F.PROJ + (rowq + r32) * PW + C_AQ + hq * HD + 16 * s + 8 * hi);
            const int kt_lo = (nb == 0 && qt < 4) ? 4 - qt : 0;
            f32x16 sc[5];
#pragma unroll
            for (int k5 = 0; k5 < 5; ++k5) {
#pragma unroll
                for (int r = 0; r < 16; ++r) sc[k5][r] = NEG;
                if (k5 >= kt_lo) {
                    f32x16 acc;
#pragma unroll
                    for (int r = 0; r < 16; ++r) acc[r] = 0.f;
                    const LAS unsigned char* kp = lds + L_K + (32 * (qt + k5) + r32) * KST + hi * 16;
#pragma unroll
                    for (int s = 0; s < 4; ++s) acc = MFMA32(*(const LAS bf16x8_t*)(kp + s * 32), qf[s], acc);
#pragma unroll
                    for (int r = 0; r < 16; ++r) { const int kvl = crow(r, hi); bool ok = true; if (k5 == 0) ok = kvl > r32; if (k5 == 4) ok = kvl <= r32; sc[k5][r] = ok ? acc[r] * C2 : NEG; }
                }
            }
            float mx = sink2;
#pragma unroll
            for (int k5 = 0; k5 < 5; ++k5)
#pragma unroll
                for (int r = 0; r < 16; ++r) mx = fmaxf(mx, sc[k5][r]);
            mx = fmaxf(mx, __shfl_xor(mx, 32));
            float lsum = 0.f;
            f32x16 o[2];
#pragma unroll
            for (int r = 0; r < 16; ++r) { o[0][r] = 0.f; o[1][r] = 0.f; }
#pragma unroll
            for (int k5 = 0; k5 < 5; ++k5) {
                if (k5 >= kt_lo) {
                    float p[16];
#pragma unroll
                    for (int r = 0; r < 16; ++r) { p[r] = __builtin_amdgcn_exp2f(sc[k5][r] - mx); lsum += p[r]; }
#pragma unroll
                    for (int s2 = 0; s2 < 2; ++s2) {
                        v4u t; t.x = cvtpk(p[8 * s2], p[8 * s2 + 1]); t.y = cvtpk(p[8 * s2 + 2], p[8 * s2 + 3]); t.z = cvtpk(p[8 * s2 + 4], p[8 * s2 + 5]); t.w = cvtpk(p[8 * s2 + 6], p[8 * s2 + 7]);
                        const bf16x8_t pa = __builtin_bit_cast(bf16x8_t, t);
                        const LAS unsigned char* vp = lds + L_V + (32 * (qt + k5) + 16 * s2 + 4 * hi + q4) * VST + (16 * blk + 4 * p4) * 2;
#pragma unroll
                        for (int d0 = 0; d0 < 2; ++d0) { const bf16x8_t vb = cat8(tr_read(vp + d0 * 64), tr_read(vp + d0 * 64 + 8 * VST)); o[d0] = MFMA32(pa, vb, o[d0]); }
                    }
                }
            }
            lsum += __shfl_xor(lsum, 32);
            lsum += __builtin_amdgcn_exp2f(sink2 - mx);
            if (hi == 0) wsf[r32] = 1.0f / lsum;
#pragma unroll
            for (int r = 0; r < 16; ++r) { const int qr = crow(r, hi); const float rl = wsf[qr];
                *(LAS unsigned short*)(ost + qr * 128 + r32 * 2) = (unsigned short)f2bf(o[0][r] * rl);
                *(LAS unsigned short*)(ost + qr * 128 + (32 + r32) * 2) = (unsigned short)f2bf(o[1][r] * rl); }
#pragma unroll
            for (int i = 0; i < 4; ++i) { const int id = lane + 64 * i, row = id >> 3, ch = id & 7;
                const v4u av = *(const LAS v4u*)(ost + row * 128 + ch * 16);
                const size_t tok = rowq + row; const int cb = hq * HD + ch * 8;
                const bf16* prow = F.PROJ + tok * PW + cb;
                const v4u ga = *(const v4u*)(prow + C_GA), gb = *(const v4u*)(prow + C_GB), gr = *(const v4u*)(prow + C_GR), gg = *(const v4u*)(prow + C_GV);
                const f32x4 s0 = *(const f32x4*)(F.SSQG + tok * 32 + kvh * 8), s1 = *(const f32x4*)(F.SSQG + tok * 32 + kvh * 8 + 4);
                const float rg = 1.0f / sqrtf(((s0[0] + s0[1]) + (s0[2] + s0[3]) + (s1[0] + s1[1]) + (s1[2] + s1[3])) * (1.0f / GDV) + RMS_EPS);
                float res[8];
#pragma unroll
                for (int j = 0; j < 4; ++j) {
                    const float a0 = bflo(av[j]), a1 = bfhi(av[j]), x0 = bflo(gr[j]), x1 = bfhi(gr[j]);
                    const float l0 = bflo(gg[j]) * rg * gw8[2 * j] * (x0 * sigmoidf_(x0)), l1 = bfhi(gg[j]) * rg * gw8[2 * j + 1] * (x1 * sigmoidf_(x1));
                    res[2 * j] = sigmoidf_(bflo(ga[j])) * a0 + sigmoidf_(bflo(gb[j])) * l0;
                    res[2 * j + 1] = sigmoidf_(bfhi(ga[j])) * a1 + sigmoidf_(bfhi(gb[j])) * l1;
                }
                v4u ov; ov.x = cvtpk(res[0], res[1]); ov.y = cvtpk(res[2], res[3]); ov.z = cvtpk(res[4], res[5]); ov.w = cvtpk(res[6], res[7]);
                *(v4u*)(F.MERGED + tok * D + cb) = ov; }
        }
    }
    __syncthreads();
}

__device__ __forceinline__ void p7_final_norm(Frame& F) {
    const int gw = F.vcu * NWAVES + F.wave, NGW = F.G * NWAVES;
    f32x4 wv[8];
#pragma unroll
    for (int j = 0; j < 8; ++j) wv[j] = ((const f32x4*)F.fnorm_w)[F.lane + 64 * j];
    for (int m = gw; m < M; m += NGW) {
        float s = (F.lane < 32) ? F.SSQ3[(size_t)m * 32 + F.lane] : 0.f;
        s = wave_sum(s);
        const float rs = 1.0f / sqrtf(s * (1.0f / D) + RMS_EPS);
        GAS f32x4* xr = (GAS f32x4*)(F.out + (size_t)m * D) + F.lane;
#pragma unroll
        for (int j = 0; j < 8; ++j) { f32x4 v = xr[64 * j]; v = v * rs * wv[j]; xr[64 * j] = v; }
    }
}

struct Args { const float* in[13]; float* out; unsigned char* ws; int ph_lo, ph_hi; };
__global__ void __launch_bounds__(NTHREADS, 2) hybrid_fwd(Args args) {
    extern __shared__ __attribute__((aligned(16))) unsigned char lds[];
    Frame F;
    F.lds = (LAS unsigned char*)lds;
    F.MISC = (volatile LAS unsigned*)(F.lds + MISC_OFF);
    F.tid = threadIdx.x; F.lane = F.tid & 63; F.wave = __builtin_amdgcn_readfirstlane(F.tid >> 6);
    F.G = gridDim.x; { const int bx = blockIdx.x; F.vcu = (F.G % 8 == 0) ? (bx % 8) * (F.G / 8) + bx / 8 : bx; }
    unsigned char* ws = args.ws;
    F.ws = ws; F.ctl = (gu32*)(ws + WS_CTL);
    F.x = args.in[0]; F.norm1_w = args.in[1]; F.w_in = args.in[2]; F.gate_w2 = args.in[3]; F.gate_b = args.in[4]; F.sinks = args.in[5]; F.gnorm_w = args.in[6];
    F.w_out = args.in[7]; F.norm2_w = args.in[8]; F.w_gate = args.in[9]; F.w_up = args.in[10]; F.w_down = args.in[11]; F.fnorm_w = args.in[12];
    F.out = args.out;
    F.Win_t = (bf16*)(ws + WS_WIN); F.Wout_t = (bf16*)(ws + WS_WOUT); F.Wdown_t = (bf16*)(ws + WS_WDOWN); F.Wgu_t = (bf16*)((unsigned char*)args.out + OUT_WGU);
    F.XB = (bf16*)((unsigned char*)args.out + OUT_XB); F.MERGED = F.XB; F.PROJ = (bf16*)(ws + WS_PROJ); F.H1B = (bf16*)(ws + WS_H1B); F.FFB = (bf16*)(ws + WS_FF);
    F.RSTD1 = (float*)(ws + WS_RSTD1); F.GLR = (float*)(ws + WS_GLR); F.DEC = (float*)(ws + WS_DEC); F.SSQG = (float*)(ws + WS_SSQG); F.SSQ2 = (float*)(ws + WS_SSQ2); F.SSQ3 = (float*)(ws + WS_SSQ3);
    F.H1 = (float*)(ws + WS_H1);
    for (int u = F.tid; u < (LDS_BYTES - LDSCTL_OFF) / 4; u += NTHREADS) ((LAS unsigned*)(F.lds + LDSCTL_OFF))[u] = 0u;
    __syncthreads();
    XcdBarrier bar; bar.bar = (unsigned*)(F.ctl + CW_BAR); bar.x = 0; bar.st = nullptr;
    if (N_LAUNCHES == 1) bar = xcd_barrier_post((unsigned*)(F.ctl + CW_BAR), F.MISC + 8);
    const int lo = args.ph_lo, hi = args.ph_hi;
#define IN(k) (lo <= (k) && (k) < hi)
#define SEAM(k) do { if (IN(k) && IN((k) + 1)) xcd_barrier(bar); } while (0)

    if (IN(0)) { p0_prologue(F); SEAM(0); }
    if (IN(1)) {
        pg8::Gemm g{F.XB, F.Win_t, M, NP1, D}; pg8::StaticOrder S; S.init(M, NP1, F.G, (int)blockIdx.x);
        pg8::EpiProj E{F.PROJ, PW, F.RSTD1, F.GLR, PW / 256};
        pg8::gemm_phase<pg8::EpiProj, pg8::StaticOrder, true, true>(F.lds, g, S, E);
        SEAM(1);
    }
#if GLA_OPT
    if (IN(2)) { p2a_gla_prep(F); SEAM(2); }
    if (IN(3)) { p2b_gla_main(F); SEAM(3); }
#else
    if (IN(2)) { SEAM(2); }
    if (IN(3)) { p2_gla_naive(F); SEAM(3); }
#endif
#if ATT_OPT
    if (IN(4)) { p3_attn(F); SEAM(4); }
#else
    if (IN(4)) { p3_attn_naive(F); SEAM(4); }
#endif
    if (IN(5)) {
        pg8::Gemm g{F.MERGED, F.Wout_t, M, D, D}; pg8::StaticOrder S; S.init(M, D, F.G, (int)blockIdx.x);
        pg8::EpiRes E{F.x, F.H1, F.H1B, D, F.SSQ2};
        pg8::gemm_phase<pg8::EpiRes, pg8::StaticOrder, true, true>(F.lds, g, S, E);
        SEAM(5);
    }
    if (IN(6)) {
        pg8::Gemm g{F.H1B, F.Wgu_t, M, 2 * FF, D}; pg8::StaticOrder S; S.init(M, 2 * FF, F.G, (int)blockIdx.x);
        pg8::EpiSwiGLU E{F.FFB, FF, F.SSQ2, 1.0f / D};
        pg8::gemm_phase<pg8::EpiSwiGLU, pg8::StaticOrder, true, true>(F.lds, g, S, E);
        SEAM(6);
    }
    if (IN(7)) {
        pg8::Gemm g{F.FFB, F.Wdown_t, M, D, FF}; pg8::StaticOrder S; S.init(M, D, F.G, (int)blockIdx.x);
        pg8::EpiRes E{F.H1, F.out, nullptr, D, F.SSQ3};
        pg8::gemm_phase<pg8::EpiRes, pg8::StaticOrder, true, true>(F.lds, g, S, E);
        SEAM(7);
    }
    if (IN(8)) { p7_final_norm(F); }
#undef IN
#undef SEAM
}

extern "C" void kernel_launch(void* const* d_in, const int* in_sizes, int n_in, void* d_out, int out_size, void* d_ws, size_t ws_size, hipStream_t stream) {
    static int grid = 0;
    if (grid == 0) {
        if (n_in != 13 || in_sizes[0] != M * D || out_size != M * D || ws_size < WS_END) { fprintf(stderr, "kernel_launch: unexpected shapes (n_in %d, in0 %d, out %d, ws %zu)\n", n_in, n_in > 0 ? in_sizes[0] : -1, out_size, ws_size); grid = -1; return; }
        int dev = 0, cus = 0, per_cu = 0;
        if (hipGetDevice(&dev) != hipSuccess || hipDeviceGetAttribute(&cus, hipDeviceAttributeMultiprocessorCount, dev) != hipSuccess) { grid = -1; return; }
        if (hipFuncSetAttribute((const void*)hybrid_fwd, hipFuncAttributeMaxDynamicSharedMemorySize, LDS_BYTES) != hipSuccess) { fprintf(stderr, "kernel_launch: hipFuncSetAttribute failed\n"); grid = -1; return; }
        if (hipOccupancyMaxActiveBlocksPerMultiprocessor(&per_cu, (const void*)hybrid_fwd, NTHREADS, LDS_BYTES) != hipSuccess || per_cu < 1) { fprintf(stderr, "kernel_launch: occupancy query reports %d\n", per_cu); }
        (void)hipGetLastError();
        grid = cus;
    }
    if (grid < 0) return;
    (void)hipMemsetAsync((char*)d_ws + WS_CTL, 0, CTL_ZERO_BYTES, stream);
    Args a{};
    for (int i = 0; i < 13; ++i) a.in[i] = (const float*)d_in[i];
    a.out = (float*)d_out; a.ws = (unsigned char*)d_ws;
    if (N_LAUNCHES == 1) { a.ph_lo = 0; a.ph_hi = N_PHASES; hipLaunchKernelGGL(hybrid_fwd, dim3(grid), dim3(NTHREADS), LDS_BYTES, stream, a); }
    else for (int li = 0; li < N_PHASES; ++li) { a.ph_lo = li; a.ph_hi = li + 1; hipLaunchKernelGGL(hybrid_fwd, dim3(grid), dim3(NTHREADS), LDS_BYTES, stream, a); }
}
```

```cpp
#include <hip/hip_runtime.h>
#include <cstdio>
#include <cstdint>

#ifndef MK_N_LAUNCHES
#define MK_N_LAUNCHES 1
#endif

namespace pg8 {
#define PG8_LAS __attribute__((address_space(3)))
typedef unsigned short bf16_t;
typedef short bf16x8 __attribute__((ext_vector_type(8)));
typedef float f32x4 __attribute__((ext_vector_type(4)));
typedef unsigned u32x4 __attribute__((ext_vector_type(4)));
constexpr int BM = 256, BK = 64, HALF = 128, HTB = HALF * BK * 2  , STAGE_BYTES = 8 * HTB, NXCD = 8, WGM = 8;

__host__ __device__ __forceinline__ int lds_byte(int r, int c) { const int st = (r >> 4) * 2 + (c >> 5), rr = r & 15, cc = c & 31, ob = rr * 64 + cc * 2; return st * 1024 + (ob ^ (((ob >> 9) & 1) << 5)); }
__host__ __device__ __forceinline__ void stage_rc(int b, int& R, int& C) { const int st = b / 1024, sb = b % 1024, swz = sb ^ (((sb >> 9) & 1) << 5); R = (st >> 1) * 16 + swz / 64; C = (st & 1) * 32 + (swz % 64) / 2; }
__host__ __device__ __forceinline__ int perm32(int rho) { const int n = rho >> 4, i = rho & 15; return 8 * (i >> 2) + 4 * n + (i & 3); }

struct Unit { int pm, pn; };
struct Gemm { const bf16_t* A; const bf16_t* Bt; int M, N, K; };

struct StaticOrder {
    int nM, nN, nwg, G, c, rep;
    __host__ __device__ void init(int M, int N, int G_, int c_, int rep_ = 1) { nM = M / BM; nN = N / BM; nwg = nM * nN; G = G_; c = c_; rep = rep_; }
    __host__ __device__ bool next(int i, Unit& u) const {
        const long L = (long)i * G + c; if (L >= (long)nwg * rep) return false;
        int wgid = (int)(L % nwg); { const int q = nwg / NXCD, r = nwg % NXCD, xcd = wgid % NXCD, off = wgid / NXCD; wgid = (xcd < r ? xcd * (q + 1) : r * (q + 1) + (xcd - r) * q) + off; }
        const int nig = WGM * nN, gid = wgid / nig, fm = gid * WGM, gsz = (nM - fm) < WGM ? (nM - fm) : WGM;
        u.pm = fm + ((wgid % nig) % gsz); u.pn = (wgid % nig) / gsz; return true;
    }
    __device__ __forceinline__ void a_ready(const Unit&) const {}
    __device__ __forceinline__ void done(const Unit&) const {}
};

__device__ __forceinline__ unsigned cvt_pk_bf16(float lo, float hi) { unsigned r; asm volatile("v_cvt_pk_bf16_f32 %0, %1, %2" : "=v"(r) : "v"(lo), "v"(hi)); return r; }
__device__ __forceinline__ float sum4(const f32x4 v) { return (v[0] + v[1]) + (v[2] + v[3]); }
__device__ __forceinline__ float sq4(const f32x4 v) { return (v[0] * v[0] + v[1] * v[1]) + (v[2] * v[2] + v[3] * v[3]); }
constexpr float RMS_EPS = 1e-6f;

struct EpiProj {
    static constexpr bool PERM = true, AFTER_DRAIN = false;
    bf16_t* O; int ldc; const float* rstd; float* glr; int glr_tile;
    __device__ __forceinline__ void operator()(const f32x4 (&acc)[2][2][4][2], const Unit& u, int wr, int wc, int fr, int fq) const {
        const int row0 = u.pm * BM + wr * 64 + fr;
        float rs[2][4];
#pragma unroll
        for (int ai = 0; ai < 2; ++ai)
#pragma unroll
            for (int m = 0; m < 4; ++m) rs[ai][m] = rstd[row0 + ai * HALF + m * 16];
        if (u.pn == glr_tile) {
            if (wc == 0 && fq < 2) {
#pragma unroll
                for (int ai = 0; ai < 2; ++ai)
#pragma unroll
                    for (int m = 0; m < 4; ++m) { float* p = glr + (size_t)(row0 + ai * HALF + m * 16) * 16 + 8 * fq;
                        *(f32x4*)p = acc[ai][0][m][0] * rs[ai][m]; *(f32x4*)(p + 4) = acc[ai][0][m][1] * rs[ai][m]; }
            }
            return;
        }
        const int col0 = u.pn * BM + wc * 32 + 8 * fq;
#pragma unroll
        for (int ai = 0; ai < 2; ++ai)
#pragma unroll
            for (int m = 0; m < 4; ++m) { bf16_t* rowp = O + (size_t)(row0 + ai * HALF + m * 16) * ldc + col0; const float s = rs[ai][m];
#pragma unroll
                for (int bj = 0; bj < 2; ++bj) { const f32x4 v0 = acc[ai][bj][m][0] * s, v1 = acc[ai][bj][m][1] * s;
                    u32x4 w; w.x = cvt_pk_bf16(v0[0], v0[1]); w.y = cvt_pk_bf16(v0[2], v0[3]); w.z = cvt_pk_bf16(v1[0], v1[1]); w.w = cvt_pk_bf16(v1[2], v1[3]);
                    *(u32x4*)(rowp + bj * HALF) = w; } }
    }
};
struct EpiRes {
    static constexpr bool PERM = true, AFTER_DRAIN = false;
    const float* base; float* out; bf16_t* outb; int ldc; float* ssq;
    __device__ __forceinline__ void operator()(const f32x4 (&acc)[2][2][4][2], const Unit& u, int wr, int wc, int fr, int fq) const {
        const int row0 = u.pm * BM + wr * 64 + fr, col0 = u.pn * BM + wc * 32 + 8 * fq;
#pragma unroll
        for (int ai = 0; ai < 2; ++ai)
#pragma unroll
            for (int m = 0; m < 4; ++m) { const int row = row0 + ai * HALF + m * 16; const size_t off = (size_t)row * ldc + col0; float s = 0.f;
#pragma unroll
                for (int bj = 0; bj < 2; ++bj) { const f32x4 b0 = *(const f32x4*)(base + off + bj * HALF), b1 = *(const f32x4*)(base + off + bj * HALF + 4);
                    const f32x4 v0 = acc[ai][bj][m][0] + b0, v1 = acc[ai][bj][m][1] + b1;
                    *(f32x4*)(out + off + bj * HALF) = v0; *(f32x4*)(out + off + bj * HALF + 4) = v1;
                    if (outb) { u32x4 w; w.x = cvt_pk_bf16(v0[0], v0[1]); w.y = cvt_pk_bf16(v0[2], v0[3]); w.z = cvt_pk_bf16(v1[0], v1[1]); w.w = cvt_pk_bf16(v1[2], v1[3]); *(u32x4*)(outb + off + bj * HALF) = w; }
                    s += sq4(v0) + sq4(v1); }
                s += __shfl_xor(s, 16); s += __shfl_xor(s, 32);
                if (fq == 0) ssq[(size_t)row * 32 + u.pn * 4 + wc] = s; }
    }
};
struct EpiSwiGLU {
    static constexpr bool PERM = true, AFTER_DRAIN = false;
    bf16_t* ff; int ldc; const float* ssq; float inv_n;
    __device__ __forceinline__ void operator()(const f32x4 (&acc)[2][2][4][2], const Unit& u, int wr, int wc, int fr, int fq) const {
        const int row0 = u.pm * BM + wr * 64 + fr, col0 = u.pn * HALF + wc * 32 + 8 * fq;
#pragma unroll
        for (int ai = 0; ai < 2; ++ai)
#pragma unroll
            for (int m = 0; m < 4; ++m) { const int row = row0 + ai * HALF + m * 16;
                const f32x4* sp = (const f32x4*)(ssq + (size_t)row * 32 + fq * 8); float s = sum4(sp[0]) + sum4(sp[1]);
                s += __shfl_xor(s, 16); s += __shfl_xor(s, 32);
                const float rs = 1.0f / sqrtf(s * inv_n + RMS_EPS);
                float f[8];
#pragma unroll
                for (int n = 0; n < 2; ++n)
#pragma unroll
                    for (int i = 0; i < 4; ++i) { const float g = acc[ai][0][m][n][i] * rs, up = acc[ai][1][m][n][i] * rs;
                        f[4 * n + i] = g * __builtin_amdgcn_rcpf(1.0f + __builtin_amdgcn_exp2f(-1.4426950408889634f * g)) * up; }
                u32x4 w; w.x = cvt_pk_bf16(f[0], f[1]); w.y = cvt_pk_bf16(f[2], f[3]); w.z = cvt_pk_bf16(f[4], f[5]); w.w = cvt_pk_bf16(f[6], f[7]);
                *(u32x4*)(ff + (size_t)row * ldc + col0) = w; }
    }
};

template <class Epi, class Sched, bool ALIGN_EPI = false, bool SP2 = false>
__device__ __forceinline__ void gemm_phase(PG8_LAS unsigned char* lds, const Gemm g, const Sched& S, const Epi& E) {
    const int tid = threadIdx.x, wid = __builtin_amdgcn_readfirstlane(tid >> 6), lane = tid & 63, wr = wid >> 2, wc = wid & 3, fr = lane & 15, fq = lane >> 4;
    const int K = g.K, nt = K / BK;
    unsigned voffA[2], voffB[2];
#pragma unroll
    for (int i = 0; i < 2; ++i) { int R, C; stage_rc(tid * 16 + i * 8192, R, C); const int Rb = Epi::PERM ? ((R & ~31) + perm32(R & 31)) : R;
        voffA[i] = (unsigned)(R * K + C) * 2u; voffB[i] = (unsigned)(Rb * K + C) * 2u; }
    const size_t kstep = (size_t)(BK * 2);
    const size_t hstep = (size_t)HALF * K * 2;
    const size_t tstep = 2 * hstep;
    const unsigned ldsw = (unsigned)wid * 1024u;
    const int aoff = lds_byte(wr * 64 + fr, fq * 8), boff = lds_byte(wc * 32 + fr, fq * 8);
#define PG8_SA(b, h) (((b) * 2 + (h)) * HTB)
#define PG8_SB(b, h) ((4 + (b) * 2 + (h)) * HTB)
#define PG8_STAGE(bufoff, gbase, voff) do { _Pragma("unroll") for (int _i = 0; _i < 2; ++_i) \
        __builtin_amdgcn_global_load_lds((const unsigned*)((const char*)(gbase) + (voff)[_i]), (PG8_LAS unsigned*)(lds + (bufoff) + ldsw + _i * 8192), 16, 0, 0); } while (0)
#define PG8_LDA(dst, b, h) do { _Pragma("unroll") for (int m = 0; m < 4; ++m) _Pragma("unroll") for (int k = 0; k < 2; ++k) dst[m][k] = *(const PG8_LAS bf16x8*)(lds + PG8_SA(b, h) + aoff + m * 2048 + k * 1024); } while (0)
#define PG8_LDB(dst, b, h) do { _Pragma("unroll") for (int n = 0; n < 2; ++n) _Pragma("unroll") for (int k = 0; k < 2; ++k) dst[n][k] = *(const PG8_LAS bf16x8*)(lds + PG8_SB(b, h) + boff + n * 2048 + k * 1024); } while (0)
#define PG8_MMA(ai, bj, At, Bt) do { __builtin_amdgcn_s_setprio(1); _Pragma("unroll") for (int m = 0; m < 4; ++m) _Pragma("unroll") for (int n = 0; n < 2; ++n) _Pragma("unroll") for (int k = 0; k < 2; ++k) \
        acc[ai][bj][m][n] = __builtin_amdgcn_mfma_f32_16x16x32_bf16(Bt[n][k], At[m][k], acc[ai][bj][m][n], 0, 0, 0); __builtin_amdgcn_s_setprio(0); } while (0)
#define PG8_WAIT_V(n) asm volatile("s_waitcnt vmcnt(" #n ")" ::: "memory")
#define PG8_WAIT_L(n) asm volatile("s_waitcnt lgkmcnt(" #n ")" ::: "memory")
#define PG8_BAR __builtin_amdgcn_s_barrier()
#define PG8_SCHED __builtin_amdgcn_sched_barrier(0)
    Unit cur, nxt; int ui = 0;
    if (!S.next(0, cur)) return;
    f32x4 acc[2][2][4][2];
#pragma unroll
    for (int a = 0; a < 2; ++a)
#pragma unroll
        for (int b = 0; b < 2; ++b)
#pragma unroll
            for (int m = 0; m < 4; ++m)
#pragma unroll
                for (int n = 0; n < 2; ++n) acc[a][b][m][n] = (f32x4){0.f, 0.f, 0.f, 0.f};
    bf16x8 At[4][2], B0[2][2], B1[2][2];
    const char* cA = (const char*)g.A + (size_t)cur.pm * tstep; const char* cB = (const char*)g.Bt + (size_t)cur.pn * tstep;
    S.a_ready(cur);
    if constexpr (SP2) {
        PG8_STAGE(PG8_SB(0, 0), cB, voffB); PG8_STAGE(PG8_SB(0, 1), cB + hstep, voffB); PG8_STAGE(PG8_SA(0, 0), cA, voffA); PG8_STAGE(PG8_SA(0, 1), cA + hstep, voffA);
        if (wr == 1) PG8_BAR;
        PG8_WAIT_V(2); PG8_BAR;
        PG8_STAGE(PG8_SB(1, 0), cB + kstep, voffB); PG8_STAGE(PG8_SA(1, 0), cA + kstep, voffA); PG8_STAGE(PG8_SB(1, 1), cB + hstep + kstep, voffB);
        PG8_WAIT_V(6); PG8_BAR;
    } else {
        PG8_STAGE(PG8_SB(0, 0), cB, voffB); PG8_STAGE(PG8_SA(0, 0), cA, voffA); PG8_STAGE(PG8_SB(0, 1), cB + hstep, voffB); PG8_STAGE(PG8_SA(0, 1), cA + hstep, voffA);
        if (wr == 1) PG8_BAR;
        PG8_WAIT_V(4); PG8_BAR;
        PG8_STAGE(PG8_SB(1, 0), cB + kstep, voffB); PG8_STAGE(PG8_SA(1, 0), cA + kstep, voffA); PG8_STAGE(PG8_SB(1, 1), cB + hstep + kstep, voffB);
        PG8_WAIT_V(6); PG8_BAR;
    }
    for (;;) {
        const bool has_next = S.next(ui + 1, nxt);
        const char* nA = has_next ? (const char*)g.A + (size_t)nxt.pm * tstep : cA; const char* nB = has_next ? (const char*)g.Bt + (size_t)nxt.pn * tstep : cB;
        for (int t = 0; t < nt; t += 2) {
            const bool last = (t == nt - 2);
            const char* a1 = cA + (size_t)(t + 1) * kstep;
            const char* a2 = last ? nA : cA + (size_t)(t + 2) * kstep; const char* b2 = last ? nB : cB + (size_t)(t + 2) * kstep;
            const char* a3 = a2 + kstep; const char* b3 = b2 + kstep;
            if (last && has_next) S.a_ready(nxt);
            if constexpr (SP2) {
            PG8_LDB(B0, 0, 0); PG8_LDB(B1, 0, 1); PG8_SCHED; PG8_LDA(At, 0, 0); PG8_STAGE(PG8_SA(1, 1), a1 + hstep, voffA);
            PG8_WAIT_V(8); PG8_WAIT_L(0); PG8_BAR; PG8_MMA(0, 0, At, B0); PG8_MMA(0, 1, At, B1); PG8_BAR; PG8_SCHED;
            PG8_LDA(At, 0, 1); PG8_STAGE(PG8_SB(0, 0), b2, voffB); PG8_STAGE(PG8_SB(0, 1), b2 + hstep, voffB); PG8_STAGE(PG8_SA(0, 0), a2, voffA);
            PG8_WAIT_V(8); PG8_WAIT_L(0); PG8_BAR; PG8_MMA(1, 0, At, B0); PG8_MMA(1, 1, At, B1); PG8_BAR; PG8_SCHED;
            PG8_LDB(B0, 1, 0); PG8_LDB(B1, 1, 1); PG8_SCHED; PG8_LDA(At, 1, 0); PG8_STAGE(PG8_SA(0, 1), a2 + hstep, voffA);
            PG8_WAIT_V(8); PG8_WAIT_L(0); PG8_BAR; PG8_MMA(0, 0, At, B0); PG8_MMA(0, 1, At, B1); PG8_BAR; PG8_SCHED;
            PG8_LDA(At, 1, 1); PG8_STAGE(PG8_SB(1, 0), b3, voffB); PG8_STAGE(PG8_SB(1, 1), b3 + hstep, voffB); PG8_STAGE(PG8_SA(1, 0), a3, voffA);
            PG8_WAIT_V(8); PG8_WAIT_L(0); PG8_BAR; PG8_MMA(1, 0, At, B0); PG8_MMA(1, 1, At, B1); PG8_BAR; PG8_SCHED;
            } else {
            PG8_LDB(B0, 0, 0); PG8_SCHED; PG8_LDA(At, 0, 0); PG8_STAGE(PG8_SA(1, 1), a1 + hstep, voffA);
            PG8_WAIT_L(8); PG8_BAR; PG8_WAIT_L(0); PG8_MMA(0, 0, At, B0); PG8_BAR; PG8_SCHED;
            PG8_LDB(B1, 0, 1); PG8_STAGE(PG8_SB(0, 0), b2, voffB);
            PG8_BAR; PG8_WAIT_L(0); PG8_MMA(0, 1, At, B1); PG8_BAR;
            PG8_LDA(At, 0, 1); PG8_STAGE(PG8_SA(0, 0), a2, voffA);
            PG8_BAR; PG8_WAIT_L(0); PG8_MMA(1, 0, At, B0); PG8_BAR; PG8_SCHED;
            PG8_STAGE(PG8_SB(0, 1), b2 + hstep, voffB);
            PG8_WAIT_V(6); PG8_BAR; PG8_MMA(1, 1, At, B1); PG8_BAR;
            PG8_LDB(B0, 1, 0); PG8_SCHED; PG8_LDA(At, 1, 0); PG8_STAGE(PG8_SA(0, 1), a2 + hstep, voffA);
            PG8_WAIT_L(8); PG8_BAR; PG8_WAIT_L(0); PG8_MMA(0, 0, At, B0); PG8_BAR; PG8_SCHED;
            PG8_LDB(B1, 1, 1); PG8_STAGE(PG8_SB(1, 0), b3, voffB);
            PG8_BAR; PG8_WAIT_L(0); PG8_MMA(0, 1, At, B1); PG8_BAR;
            PG8_LDA(At, 1, 1); PG8_STAGE(PG8_SA(1, 0), a3, voffA);
            PG8_BAR; PG8_WAIT_L(0); PG8_MMA(1, 0, At, B0); PG8_BAR; PG8_SCHED;
            PG8_STAGE(PG8_SB(1, 1), b3 + hstep, voffB);
            PG8_WAIT_V(6); PG8_BAR; PG8_MMA(1, 1, At, B1); PG8_BAR;
            }
        }
        if constexpr (ALIGN_EPI) { if (wr == 0) PG8_BAR; }
        if constexpr (!Epi::AFTER_DRAIN) { E(acc, cur, wr, wc, fr, fq);
#if defined(EPI_TWICE)
            asm volatile("" ::: "memory"); E(acc, cur, wr, wc, fr, fq);
#endif
            S.done(cur); }
        if (!has_next) break;
#pragma unroll
        for (int a = 0; a < 2; ++a)
#pragma unroll
            for (int b = 0; b < 2; ++b)
#pragma unroll
                for (int m = 0; m < 4; ++m)
#pragma unroll
                    for (int n = 0; n < 2; ++n) acc[a][b][m][n] = (f32x4){0.f, 0.f, 0.f, 0.f};
        cur = nxt; cA = nA; cB = nB; ++ui;
        if constexpr (ALIGN_EPI) { if (wr == 1) PG8_BAR; }
    }
    PG8_WAIT_V(0);
    if constexpr (!ALIGN_EPI) { if (wr == 0) PG8_BAR; }
    PG8_BAR;
    if constexpr (Epi::AFTER_DRAIN) { E.fused(acc, cur, wr, wc, fr, fq, lds, wid, lane); S.done(cur); }
#undef PG8_SA
#undef PG8_SB
#undef PG8_STAGE
#undef PG8_LDA
#undef PG8_LDB
#undef PG8_MMA
#undef PG8_WAIT_V
#undef PG8_WAIT_L
#undef PG8_BAR
#undef PG8_SCHED
}
}

#ifndef GLA_OPT
#define GLA_OPT 1
#endif
#ifndef ATT_OPT
#define ATT_OPT 1
#endif
constexpr int NWAVES = 8, NTHREADS = NWAVES * 64;
constexpr int N_LAUNCHES = MK_N_LAUNCHES;
constexpr int N_PHASES = 9;
constexpr int BATCH = 8, SEQ = 2048, D = 2048, M = BATCH * SEQ;
constexpr int HD = 64, NQH = 32, NKVH = 4, GQA = 8, WIN = 128;
constexpr int GH = 4, GDK = 256, GDV = 512, GRANK = 16, GCHUNK = 64;
constexpr int FF = 5632;
constexpr int DIN = 12816;
constexpr int PW = 12800;
constexpr int NP1 = 13056;
constexpr int C_AQ = 0, C_AK = 2048, C_AV = 2304, C_GQ = 2560, C_GK = 3584, C_GV = 4608, C_GR = 6656, C_GA = 8704, C_GB = 10752;
constexpr int SRC_GLR = 6656;
constexpr float RMS_EPS = 1e-6f;

constexpr size_t MiB = 1u << 20;
constexpr size_t WS_CTL = 0, CTL_ZERO_BYTES = 64 * 1024;
constexpr size_t WS_RSTD1 = 1 * MiB;
constexpr size_t WS_GLR = 2 * MiB;
constexpr size_t WS_DEC = 3 * MiB;
constexpr size_t WS_SSQG = 4 * MiB;
constexpr size_t WS_SSQ2 = 6 * MiB;
constexpr size_t WS_SSQ3 = 8 * MiB;
constexpr size_t WS_WOUT = 10 * MiB;
constexpr size_t WS_WDOWN = 18 * MiB;
constexpr size_t WS_WIN = 40 * MiB;
constexpr size_t WS_PROJ = 92 * MiB;
constexpr size_t WS_H1 = WS_PROJ;
constexpr size_t WS_H1B = WS_PROJ + 128 * MiB;
constexpr size_t WS_FF = WS_PROJ + 192 * MiB;
constexpr size_t WS_END = 492 * MiB;
static_assert(WS_WIN + (size_t)NP1 * D * 2 <= WS_PROJ && WS_PROJ + (size_t)M * PW * 2 <= WS_END && WS_FF + (size_t)M * FF * 2 <= WS_END && WS_WDOWN + (size_t)D * FF * 2 <= WS_WIN, "ws map");
constexpr size_t OUT_XB = 0;
constexpr size_t OUT_G3 = 108 * MiB;
constexpr size_t OUT_WGU = 64 * MiB;
constexpr int CW_BAR = 1024;

constexpr int RING_BYTES = 131072, LDSCTL_OFF = RING_BYTES, MISC_OFF = LDSCTL_OFF + 320, LDS_BYTES = 147456;

#define GAS __attribute__((address_space(1)))
#define LAS __attribute__((address_space(3)))
typedef unsigned short bf16;
typedef unsigned v4u __attribute__((ext_vector_type(4)));
typedef unsigned v2u __attribute__((ext_vector_type(2)));
typedef float f32x4 __attribute__((ext_vector_type(4)));
typedef GAS unsigned gu32;
#define LDS_WAIT() asm volatile("s_waitcnt lgkmcnt(0)" ::: "memory")
#define VM_WAIT() asm volatile("s_waitcnt vmcnt(0)" ::: "memory")
__device__ __forceinline__ unsigned f2bf(float f) { unsigned u = __builtin_bit_cast(unsigned, f); return (u + 0x7fffu + ((u >> 16) & 1u)) >> 16; }
__device__ __forceinline__ unsigned pk2(float lo, float hi) { return f2bf(lo) | (f2bf(hi) << 16); }
__device__ __forceinline__ float bf2f(unsigned short b) { return __builtin_bit_cast(float, (unsigned)b << 16); }
__device__ __forceinline__ float bflo(unsigned w) { return __builtin_bit_cast(float, w << 16); }
__device__ __forceinline__ float bfhi(unsigned w) { return __builtin_bit_cast(float, w & 0xffff0000u); }
__device__ __forceinline__ float sigmoidf_(float x) { return 1.0f / (1.0f + __expf(-x)); }

#define XB_TMO      128
#define XB_XCNT(j)  (256  + 64 * (j))
#define XB_XSUB(j)  (1280 + 64 * (j))
#define XB_XGEN(j)  (2304 + 64 * (j))
#define XB_TOP      3328
#define XB_TOPGEN   3392
#define XCD_BAR_WORDS 3456
#define XB_SPIN_CAP (1u << 22)
static_assert((CW_BAR + XCD_BAR_WORDS) * 4 <= (int)CTL_ZERO_BYTES, "barrier words inside the memset region");

__device__ __forceinline__ unsigned xb_ld(unsigned* p)              { return __hip_atomic_load(p, __ATOMIC_RELAXED, __HIP_MEMORY_SCOPE_AGENT); }
__device__ __forceinline__ unsigned xb_add(unsigned* p, unsigned v) { return __hip_atomic_fetch_add(p, v, __ATOMIC_RELAXED, __HIP_MEMORY_SCOPE_AGENT); }
__device__ __forceinline__ unsigned xb_xcc_id() { return (unsigned)__builtin_amdgcn_s_getreg((3 << 11) | 20) & 0xFu; }
#define XB_SPIN(cond, bar) do { unsigned _sp = 0; while (cond) { __builtin_amdgcn_s_sleep(1); \
    if ((++_sp & 255u) == 0u) { if (xb_ld(&(bar)[XB_TMO])) break; if (_sp > XB_SPIN_CAP) { atomicAdd(&(bar)[XB_TMO], 1u); break; } } } } while (0)

struct XcdBarrier { unsigned* bar; unsigned x; volatile LAS unsigned* st; };

__device__ __forceinline__ XcdBarrier xcd_barrier_post(unsigned* bar, volatile LAS unsigned* st) {
    XcdBarrier b; b.bar = bar; b.x = xb_xcc_id(); b.st = st;
    if (threadIdx.x == 0) (void)xb_add(&bar[XB_XCNT(b.x)], 1u);
    return b;
}
__device__ __forceinline__ void xcd_barrier_complete(unsigned* bar, unsigned x, unsigned& nloc, unsigned& nx) {
    const unsigned G = gridDim.x * gridDim.y * gridDim.z;
    unsigned sum, cnt, mine, sp = 0u;
    for (;;) {
        sum = 0u; cnt = 0u; mine = 0u;
#pragma unroll
        for (unsigned j = 0; j < 16; ++j) { const unsigned c = xb_ld(&bar[XB_XCNT(j)]); sum += c; cnt += (c > 0u) ? 1u : 0u; mine = (j == x) ? c : mine; }
        if (sum == G) break;
        __builtin_amdgcn_s_sleep(1);
        if ((++sp & 255u) == 0u) { if (xb_ld(&bar[XB_TMO])) break; if (sp > XB_SPIN_CAP) { atomicAdd(&bar[XB_TMO], 1u); break; } }
    }
    nloc = mine > 0u ? mine : 1u; nx = cnt > 0u ? cnt : 1u;
}
__device__ __forceinline__ void xcd_barrier(const XcdBarrier& b) {
    asm volatile("s_waitcnt vmcnt(0)" ::: "memory");
    __syncthreads();
    if (threadIdx.x == 0) {
        unsigned* bar = b.bar;
        __builtin_amdgcn_s_waitcnt(0);
        unsigned nloc = b.st[0], nx = b.st[1];
        if (nloc == 0u) { xcd_barrier_complete(bar, b.x, nloc, nx); b.st[0] = nloc; b.st[1] = nx; }
        const unsigned old = xb_add(&bar[XB_XSUB(b.x)], 1u);
        const unsigned gen = old / nloc;
        if (old + 1u == (gen + 1u) * nloc) {
            __builtin_amdgcn_fence(__ATOMIC_RELEASE, "agent");
            asm volatile("s_waitcnt vmcnt(0)" ::: "memory");
            const unsigned og = xb_add(&bar[XB_TOP], 1u);
            const unsigned tg = og / nx;
            if (og + 1u == (tg + 1u) * nx) xb_add(&bar[XB_TOPGEN], 1u);
            else XB_SPIN(xb_ld(&bar[XB_TOPGEN]) == tg, bar);
            __builtin_amdgcn_fence(__ATOMIC_ACQUIRE, "agent");
            xb_add(&bar[XB_XGEN(b.x)], 1u);
            asm volatile("s_waitcnt vmcnt(0)" ::: "memory");
        } else {
            XB_SPIN(xb_ld(&bar[XB_XGEN(b.x)]) == gen, bar);
            __builtin_amdgcn_fence(__ATOMIC_ACQUIRE, "agent");
            asm volatile("s_waitcnt vmcnt(0)" ::: "memory");
        }
    }
    __syncthreads();
}

struct Frame {
    LAS unsigned char* lds;
    volatile LAS unsigned* MISC;
    gu32* ctl;
    int tid, lane, wave, vcu, G;
    const float *x, *norm1_w, *w_in, *gate_w2, *gate_b, *sinks, *gnorm_w, *w_out, *norm2_w, *w_gate, *w_up, *w_down, *fnorm_w;
    float* out;
    unsigned char* ws;
    bf16 *Win_t, *Wout_t, *Wgu_t, *Wdown_t, *XB, *PROJ, *MERGED, *H1B, *FFB;
    float *RSTD1, *GLR, *DEC, *SSQG, *SSQ2, *SSQ3, *H1;
    bf16 *G012, *G3;
};

__device__ __forceinline__ float wave_sum(float v) {
#pragma unroll
    for (int o = 1; o < 64; o <<= 1) v += __shfl_xor(v, o);
    return v;
}

typedef short bf16x8_t __attribute__((ext_vector_type(8)));
typedef short s16x4_t __attribute__((ext_vector_type(4)));
typedef float f32x16 __attribute__((ext_vector_type(16)));
__device__ __forceinline__ unsigned cvtpk(float lo, float hi) { typedef float f2 __attribute__((ext_vector_type(2))); typedef __bf16 b2 __attribute__((ext_vector_type(2)));
    f2 v = {lo, hi}; b2 b = __builtin_convertvector(v, b2); return __builtin_bit_cast(unsigned, b); }
__device__ __forceinline__ s16x4_t tr_read(LAS const unsigned char* p) { return __builtin_bit_cast(s16x4_t, __builtin_amdgcn_ds_read_tr16_b64_v4i16((LAS s16x4_t*)p)); }
__device__ __forceinline__ bf16x8_t cat8(s16x4_t lo, s16x4_t hi) { return __builtin_shufflevector(lo, hi, 0, 1, 2, 3, 4, 5, 6, 7); }
#define MFMA16(a, b, c) __builtin_amdgcn_mfma_f32_16x16x32_bf16((a), (b), (c), 0, 0, 0)
#define MFMA32(a, b, c) __builtin_amdgcn_mfma_f32_32x32x16_bf16((a), (b), (c), 0, 0, 0)

__device__ __forceinline__ void p0_transpose_item(const float* srcp, int ldw, const float* kscale, int K, bf16* WTrow0, LAS unsigned char* scr, int k0, int lane) {
    constexpr int RS = 144;
    const int kr = lane >> 4, n4 = (lane & 15) * 4;
    f32x4 v[16];
#pragma unroll
    for (int i = 0; i < 16; ++i) { v[i] = (f32x4){0.f, 0.f, 0.f, 0.f}; if (srcp) v[i] = *(const f32x4*)(srcp + (size_t)(k0 + 4 * i + kr) * ldw); }
    if (kscale) {
#pragma unroll
        for (int i = 0; i < 16; ++i) v[i] = v[i] * kscale[k0 + 4 * i + kr];
    }
#pragma unroll
    for (int i = 0; i < 16; ++i) { v2u w; w.x = cvtpk(v[i][0], v[i][1]); w.y = cvtpk(v[i][2], v[i][3]); *(LAS v2u*)(scr + (4 * i + kr) * RS + n4 * 2) = w; }
    const int G = lane >> 4, i16 = lane & 15, q = i16 >> 2, p = i16 & 3;
#pragma unroll
    for (int ng = 0; ng < 4; ++ng)
#pragma unroll
        for (int u = 0; u < 2; ++u) { const LAS unsigned char* rp = scr + (8 * (G + 4 * u) + q) * RS + (16 * ng + 4 * p) * 2;
            const bf16x8_t t = cat8(tr_read(rp), tr_read(rp + 4 * RS));
            *(GAS bf16x8_t*)(WTrow0 + (size_t)(16 * ng + i16) * K + k0 + 8 * (G + 4 * u)) = t; }
    LDS_WAIT(); asm volatile("" ::: "memory");
}
__device__ __forceinline__ void p0_prologue(Frame& F) {
    LAS unsigned char* scr = F.lds + F.wave * 16384;
    const int gw = F.vcu * NWAVES + F.wave, NGW = F.G * NWAVES;
    constexpr int I_IN = (D / 64) * (NP1 / 64), I_OUT = (D / 64) * (D / 64), I_GU = (D / 64) * (2 * FF / 64), I_DN = (FF / 64) * (D / 64);
    constexpr int NITEMS = I_IN + I_OUT + I_GU + I_DN;
    const int n4 = (F.lane & 15) * 4;
    for (int it = gw; it < NITEMS; it += NGW) {
        int r = it;
        if (r < I_IN) { const int nblk = NP1 / 64, kb = r / nblk, nb = r % nblk, n = nb * 64 + n4;
            const int sc = n < SRC_GLR ? n : (n < PW ? n + GRANK : (n < PW + GRANK ? SRC_GLR + (n - PW) : -1));
            p0_transpose_item(sc >= 0 ? F.w_in + sc : nullptr, DIN, F.norm1_w, D, F.Win_t + (size_t)(nb * 64) * D, scr, kb * 64, F.lane); continue; }
        r -= I_IN;
        if (r < I_OUT) { const int nblk = D / 64, kb = r / nblk, nb = r % nblk;
            p0_transpose_item(F.w_out + nb * 64 + n4, D, nullptr, D, F.Wout_t + (size_t)(nb * 64) * D, scr, kb * 64, F.lane); continue; }
        r -= I_OUT;
        if (r < I_GU) { const int nblk = 2 * FF / 64, kb = r / nblk, nb = r % nblk, n0 = nb * 64, pn = n0 >> 8, bj = (n0 >> 7) & 1, hl = (n0 & 127) + n4;
            p0_transpose_item((bj ? F.w_up : F.w_gate) + pn * 128 + hl, FF, F.norm2_w, D, F.Wgu_t + (size_t)n0 * D, scr, kb * 64, F.lane); continue; }
        r -= I_GU;
        { const int nblk = D / 64, kb = r / nblk, nb = r % nblk;
            p0_transpose_item(F.w_down + nb * 64 + n4, D, nullptr, FF, F.Wdown_t + (size_t)(nb * 64) * FF, scr, kb * 64, F.lane); }
    }
    for (int m = gw; m < M; m += NGW) {
        const GAS f32x4* xr = (const GAS f32x4*)(F.x + (size_t)m * D) + F.lane;
        f32x4 v[8]; float s = 0.f;
#pragma unroll
        for (int j = 0; j < 8; ++j) { v[j] = xr[64 * j]; s += (v[j].x * v[j].x + v[j].y * v[j].y) + (v[j].z * v[j].z + v[j].w * v[j].w); }
        s = wave_sum(s);
        if (F.lane == 0) F.RSTD1[m] = 1.0f / sqrtf(s * (1.0f / D) + RMS_EPS);
        GAS v2u* o8 = (GAS v2u*)(F.XB + (size_t)m * D) + F.lane;
#pragma unroll
        for (int j = 0; j < 8; ++j) { v2u w; w.x = cvtpk(v[j].x, v[j].y); w.y = cvtpk(v[j].z, v[j].w); o8[64 * j] = w; }
    }
}

__device__ __forceinline__ void p2_gla_naive(Frame& F) {
    float* al = (float*)(F.lds);
    float* kk = al + 256;
    float* qq = kk + 256;
    float* vv = qq + 256;
    float* red = vv + 64;
    const int tid = F.tid, lane = F.lane, wave = F.wave;
    const int vl = tid >> 3, dq = tid & 7;
    for (int unit = blockIdx.x; unit < BATCH * GH * 8; unit += gridDim.x) {
        const int b = unit >> 5, h = (unit >> 3) & 3, vs = unit & 7;
        float S[32];
#pragma unroll
        for (int d = 0; d < 32; ++d) S[d] = 0.f;
        float w2r[16]; float bias = 0.f;
        const int dch = tid & 255;
#pragma unroll
        for (int r = 0; r < 16; ++r) w2r[r] = F.gate_w2[r * (GH * GDK) + h * GDK + dch];
        bias = F.gate_b[h * GDK + dch];
        for (int t = 0; t < SEQ; ++t) {
            const size_t row = (size_t)b * SEQ + t;
            const bf16* prow = F.PROJ + row * PW;
            if (tid < 256) {
                const f32x4* g4 = (const f32x4*)(F.GLR + row * 16);
                float logit = bias;
#pragma unroll
                for (int r4 = 0; r4 < 4; ++r4) { const f32x4 g = g4[r4]; logit += g[0] * w2r[4 * r4] + g[1] * w2r[4 * r4 + 1] + g[2] * w2r[4 * r4 + 2] + g[3] * w2r[4 * r4 + 3]; }
                const float ls = fminf(logit, 0.f) - log1pf(expf(-fabsf(logit)));
                al[tid] = expf(ls * (1.0f / 16.0f));
                qq[tid] = bf2f(prow[C_GQ + h * GDK + tid]) * (1.0f / 16.0f);
                kk[tid] = bf2f(prow[C_GK + h * GDK + tid]);
            } else if (tid < 320) {
                vv[tid - 256] = bf2f(prow[C_GV + h * GDV + vs * 64 + (tid - 256)]);
            }
            __syncthreads();
            const float v = vv[vl]; float acc = 0.f;
#pragma unroll
            for (int d = 0; d < 32; ++d) { const int dd = dq * 32 + d; S[d] = al[dd] * S[d] + kk[dd] * v; acc += qq[dd] * S[d]; }
            acc += __shfl_xor(acc, 1); acc += __shfl_xor(acc, 2); acc += __shfl_xor(acc, 4);
            const float ob = bf2f((unsigned short)f2bf(acc));
            float o2 = ob * ob;
            o2 += __shfl_xor(o2, 8); o2 += __shfl_xor(o2, 16); o2 += __shfl_xor(o2, 32);
            if (lane == 0) red[wave] = o2;
            if (dq == 0) ((bf16*)prow)[C_GV + h * GDV + vs * 64 + vl] = (bf16)f2bf(acc);
            __syncthreads();
            if (tid == 0) { float s = 0.f;
#pragma unroll
                for (int w = 0; w < 8; ++w) s += red[w];
                F.SSQG[row * 32 + h * 8 + vs] = s; }
        }
        __syncthreads();
    }
}

__device__ __forceinline__ void p3_attn_naive(Frame& F) {
    constexpr int KST = 66;
    bf16* Ks = (bf16*)F.lds;
    bf16* Vs = Ks + 256 * KST;
    const int tid = F.tid;
    for (int unit = blockIdx.x; unit < BATCH * 16 * NKVH; unit += gridDim.x) {
        const int b = unit >> 6, nb = (unit >> 2) & 15, kvh = unit & 3;
        __syncthreads();
        for (int c = tid; c < 256 * 32; c += NTHREADS) {
            const int j = c >> 5, w = c & 31; const int tok = (nb - 1) * WIN + j;
            unsigned kw = 0u, vw = 0u;
            if (tok >= 0) { const bf16* prow = F.PROJ + ((size_t)b * SEQ + tok) * PW;
                kw = *(const unsigned*)(prow + C_AK + kvh * HD + 2 * w); vw = *(const unsigned*)(prow + C_AV + kvh * HD + 2 * w); }
            *(unsigned*)(Ks + j * KST + 2 * w) = kw; *(unsigned*)(Vs + j * KST + 2 * w) = vw;
        }
        __syncthreads();
        const int g = tid >> 6, hq = kvh * GQA + g;
        const float sink = F.sinks[hq];
        for (int rep = 0; rep < 2; ++rep) {
            const int i = (tid & 63) + 64 * rep;
            const size_t row = (size_t)b * SEQ + nb * WIN + i;
            const bf16* prow = F.PROJ + row * PW;
            float q[64], o[64];
#pragma unroll
            for (int d2 = 0; d2 < 32; ++d2) { const unsigned w = *(const unsigned*)(prow + C_AQ + hq * HD + 2 * d2); q[2 * d2] = bflo(w) * 0.125f; q[2 * d2 + 1] = bfhi(w) * 0.125f; o[2 * d2] = 0.f; o[2 * d2 + 1] = 0.f; }
            float mx = sink, l = 1.0f;
            for (int jj = 1; jj <= WIN; ++jj) {
                const int ki = i + jj;
                if (nb == 0 && ki < WIN) continue;
                const unsigned* kr = (const unsigned*)(Ks + ki * KST);
                float s = 0.f;
#pragma unroll
                for (int d2 = 0; d2 < 32; ++d2) { const unsigned w = kr[d2]; s += q[2 * d2] * bflo(w) + q[2 * d2 + 1] * bfhi(w); }
                const float mn = fmaxf(mx, s), sc = __expf(mx - mn), p = __expf(s - mn);
                l = l * sc + p; mx = mn;
                const unsigned* vr = (const unsigned*)(Vs + ki * KST);
#pragma unroll
                for (int d2 = 0; d2 < 32; ++d2) { const unsigned w = vr[d2]; o[2 * d2] = o[2 * d2] * sc + p * bflo(w); o[2 * d2 + 1] = o[2 * d2 + 1] * sc + p * bfhi(w); }
            }
            const float il = 1.0f / l;
            float sg = 0.f;
#pragma unroll
            for (int s8 = 0; s8 < 8; ++s8) sg += F.SSQG[row * 32 + kvh * 8 + s8];
            const float rg = 1.0f / sqrtf(sg * (1.0f / GDV) + RMS_EPS);
            const int cb = hq * HD;
            bf16* mrow = F.MERGED + row * D + cb;
#pragma unroll
            for (int d2 = 0; d2 < 32; ++d2) {
                const unsigned wa = *(const unsigned*)(prow + C_GA + cb + 2 * d2), wb = *(const unsigned*)(prow + C_GB + cb + 2 * d2);
                const unsigned wr_ = *(const unsigned*)(prow + C_GR + cb + 2 * d2), wg = *(const unsigned*)(prow + C_GV + cb + 2 * d2);
                const float gr0 = bflo(wr_), gr1 = bfhi(wr_);
                const float gl0 = bflo(wg) * rg * F.gnorm_w[g * HD + 2 * d2] * (gr0 * sigmoidf_(gr0));
                const float gl1 = bfhi(wg) * rg * F.gnorm_w[g * HD + 2 * d2 + 1] * (gr1 * sigmoidf_(gr1));
                const float m0 = sigmoidf_(bflo(wa)) * (o[2 * d2] * il) + sigmoidf_(bflo(wb)) * gl0;
                const float m1 = sigmoidf_(bfhi(wa)) * (o[2 * d2 + 1] * il) + sigmoidf_(bfhi(wb)) * gl1;
                *(unsigned*)(mrow + 2 * d2) = pk2(m0, m1);
            }
        }
    }
    __syncthreads();
}

__device__ __forceinline__ void p2a_gla_prep(Frame& F) {
    LAS float* glr_s = (LAS float*)F.lds;
    LAS float* tot = glr_s + 64 * 16;
    const int tid = F.tid, cp = tid & 127, tg = tid >> 7, d0 = 2 * cp;
    for (int unit = F.vcu; unit < BATCH * 32 * GH; unit += F.G) {
        const int b = unit >> 7, c = (unit >> 2) & 31, h = unit & 3;
        const size_t row0 = (size_t)b * SEQ + c * GCHUNK;
        __syncthreads();
        if (tid < 256) ((LAS f32x4*)glr_s)[tid] = ((const f32x4*)(F.GLR + row0 * 16))[tid];
        float wa[16], wb[16];
#pragma unroll
        for (int r = 0; r < 16; ++r) { const float2 w = *(const float2*)(F.gate_w2 + r * (GH * GDK) + h * GDK + d0); wa[r] = w.x; wb[r] = w.y; }
        const float2 bb = *(const float2*)(F.gate_b + h * GDK + d0);
        __syncthreads();
        float ga[16], gb[16]; float ca = 0.f, cb = 0.f;
#pragma unroll
        for (int i = 0; i < 16; ++i) {
            const LAS f32x4* g4 = (const LAS f32x4*)(glr_s + (16 * tg + i) * 16);
            float la = bb.x, lb = bb.y;
#pragma unroll
            for (int r4 = 0; r4 < 4; ++r4) { const f32x4 g = g4[r4];
                la += g[0] * wa[4 * r4] + g[1] * wa[4 * r4 + 1] + g[2] * wa[4 * r4 + 2] + g[3] * wa[4 * r4 + 3];
                lb += g[0] * wb[4 * r4] + g[1] * wb[4 * r4 + 1] + g[2] * wb[4 * r4 + 2] + g[3] * wb[4 * r4 + 3]; }
            const float sa = fminf(la, 0.f) - log1pf(__expf(-fabsf(la))), sb = fminf(lb, 0.f) - log1pf(__expf(-fabsf(lb)));
            ca += sa * (1.0f / 16.0f); cb += sb * (1.0f / 16.0f); ga[i] = ca; gb[i] = cb;
        }
        tot[tg * 256 + d0] = ca; tot[tg * 256 + d0 + 1] = cb;
        __syncthreads();
        float pa = 0.f, pb = 0.f;
#pragma unroll
        for (int t = 0; t < 3; ++t) if (t < tg) { pa += tot[t * 256 + d0]; pb += tot[t * 256 + d0 + 1]; }
        bf16* base = F.PROJ + (row0 + 16 * tg) * PW + h * GDK + d0;
#pragma unroll
        for (int i = 0; i < 16; ++i) {
            const float ea = __expf(pa + ga[i]), eb = __expf(pb + gb[i]);
            unsigned* qp = (unsigned*)(base + (size_t)i * PW + C_GQ); unsigned* kp = (unsigned*)(base + (size_t)i * PW + C_GK);
            const unsigned qw = *qp, kw = *kp;
            *qp = cvtpk(bflo(qw) * ea * (1.0f / 16.0f), bfhi(qw) * eb * (1.0f / 16.0f));
            *kp = cvtpk(bflo(kw) / ea, bfhi(kw) / eb);
        }
        if (tg == 3) { float2 dv; dv.x = __expf(pa + ca); dv.y = __expf(pb + cb); *(float2*)(F.DEC + (size_t)(b * 32 + c) * (GH * GDK) + h * GDK + d0) = dv; }
    }
    __syncthreads();
}

__device__ __forceinline__ void p2b_gla_main(Frame& F) {
    constexpr int QST = 528, VST = 144, AST = 144, OST = 272;
    constexpr int L_QD = 0, L_KI = 64 * QST, L_V = 2 * 64 * QST, L_ATT = L_V + 64 * VST, L_OP = L_ATT + 64 * AST, L_DEC = L_OP + 2 * 64 * OST, L_END = L_DEC + 1024;
    static_assert(L_END <= RING_BYTES, "gla lds");
    LAS unsigned char* lds = F.lds;
    const int tid = F.tid, lane = F.lane, w = F.wave, cw = w & 3, kh = w >> 2, c16 = lane & 15, g = lane >> 4, q4 = (lane & 15) >> 2, p4 = lane & 3;
    for (int i = tid; i < 64 * AST / 4; i += NTHREADS) ((LAS unsigned*)(lds + L_ATT))[i] = 0u;
    for (int unit = F.vcu; unit < BATCH * GH * 8; unit += F.G) {
        const int b = unit >> 5, h = (unit >> 3) & 3, vs = unit & 7;
        f32x4 S[8];
#pragma unroll
        for (int t = 0; t < 8; ++t) S[t] = (f32x4){0.f, 0.f, 0.f, 0.f};
        v4u pq[4], pk[4], pv; float pdec = 0.f;
        const bf16* gq0 = F.PROJ + (size_t)b * SEQ * PW + C_GQ + h * GDK;
        const bf16* gk0 = F.PROJ + (size_t)b * SEQ * PW + C_GK + h * GDK;
        const bf16* gv0 = F.PROJ + (size_t)b * SEQ * PW + C_GV + h * GDV + vs * 64;
        const int gpitch = (h < 3) ? 1536 : 512;
        bf16* go0 = ((h < 3) ? F.G012 + h * GDV : F.G3) + (size_t)b * SEQ * gpitch + vs * 64;
        const float* dec0 = F.DEC + (size_t)b * 32 * (GH * GDK) + h * GDK;
#define GLA_LOAD(c) do { const size_t r0_ = (size_t)(c) * GCHUNK; \
        _Pragma("unroll") for (int i_ = 0; i_ < 4; ++i_) { const int id_ = tid + NTHREADS * i_, row_ = id_ >> 5, ch_ = id_ & 31; \
            pq[i_] = *(const v4u*)(gq0 + (r0_ + row_) * PW + ch_ * 8); pk[i_] = *(const v4u*)(gk0 + (r0_ + row_) * PW + ch_ * 8); } \
        pv = *(const v4u*)(gv0 + (r0_ + (tid >> 3)) * PW + (tid & 7) * 8); \
        if (tid < 256) pdec = dec0[(size_t)(c) * (GH * GDK) + tid]; } while (0)
#define GLA_STORE() do { \
        _Pragma("unroll") for (int i_ = 0; i_ < 4; ++i_) { const int id_ = tid + NTHREADS * i_, row_ = id_ >> 5, ch_ = id_ & 31; \
            *(LAS v4u*)(lds + L_QD + row_ * QST + ch_ * 16) = pq[i_]; *(LAS v4u*)(lds + L_KI + row_ * QST + ch_ * 16) = pk[i_]; } \
        *(LAS v4u*)(lds + L_V + (tid >> 3) * VST + (tid & 7) * 16) = pv; \
        if (tid < 256) *(LAS float*)(lds + L_DEC + tid * 4) = pdec; } while (0)
        __syncthreads();
        GLA_LOAD(0); GLA_STORE();
        __syncthreads();
        for (int c = 0; c < SEQ / GCHUNK; ++c) {
            if (c + 1 < SEQ / GCHUNK) GLA_LOAD(c + 1);
#pragma unroll
            for (int tt = 0; tt < 2; ++tt) { const int tile = 2 * w + tt, it = tile >> 2, jt = tile & 3;
                if (jt <= it) {
                    f32x4 acc = {0.f, 0.f, 0.f, 0.f};
                    const LAS unsigned char* ap = lds + L_QD + (16 * it + c16) * QST + g * 16; const LAS unsigned char* bp = lds + L_KI + (16 * jt + c16) * QST + g * 16;
#pragma unroll
                    for (int s = 0; s < 8; ++s) { const bf16x8_t a = *(const LAS bf16x8_t*)(ap + s * 64), bb = *(const LAS bf16x8_t*)(bp + s * 64); acc = MFMA16(a, bb, acc); }
#pragma unroll
                    for (int r = 0; r < 4; ++r) { float v = acc[r]; if (it == jt && c16 > 4 * g + r) v = 0.f;
                        *(LAS unsigned short*)(lds + L_ATT + (16 * it + 4 * g + r) * AST + (16 * jt + c16) * 2) = (unsigned short)f2bf(v); }
                }
            }
            __syncthreads();
            bf16x8_t vf[2];
#pragma unroll
            for (int s = 0; s < 2; ++s) { const LAS unsigned char* vp = lds + L_V + (32 * s + 8 * g + q4) * VST + (16 * cw + 4 * p4) * 2; vf[s] = cat8(tr_read(vp), tr_read(vp + 4 * VST)); }
            bf16x8_t sb[4];
#pragma unroll
            for (int s = 0; s < 4; ++s) { v4u t; t.x = cvtpk(S[2 * s][0], S[2 * s][1]); t.y = cvtpk(S[2 * s][2], S[2 * s][3]); t.z = cvtpk(S[2 * s + 1][0], S[2 * s + 1][1]); t.w = cvtpk(S[2 * s + 1][2], S[2 * s + 1][3]); sb[s] = __builtin_bit_cast(bf16x8_t, t); }
#pragma unroll
            for (int it = 0; it < 4; ++it) {
                f32x4 oa = {0.f, 0.f, 0.f, 0.f};
                { const bf16x8_t a = *(const LAS bf16x8_t*)(lds + L_ATT + (16 * it + c16) * AST + (32 * kh + 8 * g) * 2); oa = MFMA16(a, kh ? vf[1] : vf[0], oa); }
                const LAS unsigned char* qp = lds + L_QD + (16 * it + c16) * QST + (128 * kh + 4 * g) * 2;
#pragma unroll
                for (int s = 0; s < 4; ++s) { const s16x4_t lo = *(const LAS s16x4_t*)(qp + s * 64), hi = *(const LAS s16x4_t*)(qp + s * 64 + 32); oa = MFMA16(cat8(lo, hi), sb[s], oa); }
#pragma unroll
                for (int r = 0; r < 4; ++r) *(LAS float*)(lds + L_OP + kh * 64 * OST + (16 * it + 4 * g + r) * OST + (16 * cw + c16) * 4) = oa[r];
            }
#pragma unroll
            for (int t = 0; t < 8; ++t) {
#pragma unroll
                for (int s = 0; s < 2; ++s) { const LAS unsigned char* kp = lds + L_KI + (32 * s + 8 * g + q4) * QST + (128 * kh + 16 * t + 4 * p4) * 2; S[t] = MFMA16(cat8(tr_read(kp), tr_read(kp + 4 * QST)), vf[s], S[t]); }
                const f32x4 dc = *(const LAS f32x4*)(lds + L_DEC + (128 * kh + 16 * t + 4 * g) * 4);
                S[t] = S[t] * dc;
            }
            __syncthreads();
            { const int row = tid >> 3, cg = tid & 7;
                const LAS f32x4* o0 = (const LAS f32x4*)(lds + L_OP + row * OST + cg * 32); const LAS f32x4* o1 = (const LAS f32x4*)(lds + L_OP + 64 * OST + row * OST + cg * 32);
                const f32x4 a = o0[0] + o1[0], bq = o0[1] + o1[1];
                v4u wv; wv.x = cvtpk(a[0], a[1]); wv.y = cvtpk(a[2], a[3]); wv.z = cvtpk(bq[0], bq[1]); wv.w = cvtpk(bq[2], bq[3]);
                const size_t grow = (size_t)c * GCHUNK + row;
                *(v4u*)(go0 + grow * gpitch + cg * 8) = wv;
                float ss = (a[0] * a[0] + a[1] * a[1]) + (a[2] * a[2] + a[3] * a[3]) + (bq[0] * bq[0] + bq[1] * bq[1]) + (bq[2] * bq[2] + bq[3] * bq[3]);
                ss += __shfl_xor(ss, 1); ss += __shfl_xor(ss, 2); ss += __shfl_xor(ss, 4);
                if (cg == 0) F.SSQG[((size_t)b * SEQ + grow) * 32 + h * 8 + vs] = ss; }
            if (c + 1 < SEQ / GCHUNK) GLA_STORE();
            __syncthreads();
        }
#undef GLA_LOAD
#undef GLA_STORE
    }
}

__device__ __forceinline__ int crow(int r, int hi) { return (r & 3) + 8 * (r >> 2) + 4 * hi; }
__device__ __forceinline__ void p3_attn(Frame& F) {
    constexpr int KST = 144, VST = 192;
    constexpr int L_K = 0, L_V = 256 * KST, L_OST = L_V + 256 * VST, L_WSF = L_OST + 8 * 4096, L_END = L_WSF + 8 * 128;
    static_assert(L_END <= RING_BYTES, "attn lds");
    LAS unsigned char* lds = F.lds;
    const int tid = F.tid, lane = F.lane, w = F.wave, r32 = lane & 31, hi = lane >> 5, q4 = (lane & 15) >> 2, p4 = lane & 3, blk = (lane >> 4) & 1;
    constexpr float C2 = 0.125f * 1.4426950408889634f, LOG2E = 1.4426950408889634f, NEG = -1e30f;
    LAS unsigned char* ost = lds + L_OST + w * 4096;
    LAS float* wsf = (LAS float*)(lds + L_WSF + w * 128);
    for (int unit = F.vcu; unit < BATCH * 16 * NKVH; unit += F.G) {
        const int b = unit >> 6, nb = (unit >> 2) & 15, kvh = unit & 3;
        __syncthreads();
#pragma unroll
        for (int i = 0; i < 4; ++i) { const int id = tid + NTHREADS * i, row = id >> 3, ch = id & 7; const int tok = (nb - 1) * WIN + row;
            v4u kv = {0u, 0u, 0u, 0u}, vv = {0u, 0u, 0u, 0u};
            if (tok >= 0) { const bf16* prow = F.PROJ + ((size_t)b * SEQ + tok) * PW + kvh * HD + ch * 8; kv = *(const v4u*)(prow + C_AK); vv = *(const v4u*)(prow + C_AV); }
            *(LAS v4u*)(lds + L_K + row * KST + ch * 16) = kv; *(LAS v4u*)(lds + L_V + row * VST + ch * 16) = vv; }
        __syncthreads();
        const int hq = kvh * GQA + w;
        const int gpitch = (kvh < 3) ? 1536 : 512; const bf16* gsrc = ((kvh < 3) ? F.G012 + kvh * GDV : F.G3) + w * HD;
        const float sink2 = F.sinks[hq] * LOG2E;
        float gw8[8];
        { const f32x4 g0 = *(const f32x4*)(F.gnorm_w + w * HD + (lane & 7) * 8), g1 = *(const f32x4*)(F.gnorm_w + w * HD + (lane & 7) * 8 + 4);
            gw8[0] = g0[0]; gw8[1] = g0[1]; gw8[2] = g0[2]; gw8[3] = g0[3]; gw8[4] = g1[0]; gw8[5] = g1[1]; gw8[6] = g1[2]; gw8[7] = g1[3]; }
        for (int qt = 0; qt < 4; ++qt) {
            const size_t rowq = (size_t)b * SEQ + nb * WIN + 32 * qt;
            bf16x8_t qf[4];
#pragma unroll
            for (int s = 0; s < 4; ++s) qf[s] = *(const bf16x8_t*)(F.PROJ + (rowq + r32) * PW + C_AQ + hq * HD + 16 * s + 8 * hi);
            const int kt_lo = (nb == 0 && qt < 4) ? 4 - qt : 0;
            f32x16 sc[5];
#pragma unroll
            for (int k5 = 0; k5 < 5; ++k5) {
#pragma unroll
                for (int r = 0; r < 16; ++r) sc[k5][r] = NEG;
                if (k5 >= kt_lo) {
                    f32x16 acc;
#pragma unroll
                    for (int r = 0; r < 16; ++r) acc[r] = 0.f;
                    const LAS unsigned char* kp = lds + L_K + (32 * (qt + k5) + r32) * KST + hi * 16;
#pragma unroll
                    for (int s = 0; s < 4; ++s) acc = MFMA32(*(const LAS bf16x8_t*)(kp + s * 32), qf[s], acc);
#pragma unroll
                    for (int r = 0; r < 16; ++r) { const int kvl = crow(r, hi); bool ok = true; if (k5 == 0) ok = kvl > r32; if (k5 == 4) ok = kvl <= r32; sc[k5][r] = ok ? acc[r] * C2 : NEG; }
                }
            }
            float mx = sink2;
#pragma unroll
            for (int k5 = 0; k5 < 5; ++k5)
#pragma unroll
                for (int r = 0; r < 16; ++r) mx = fmaxf(mx, sc[k5][r]);
            mx = fmaxf(mx, __shfl_xor(mx, 32));
            float lsum = 0.f;
            f32x16 o[2];
#pragma unroll
            for (int r = 0; r < 16; ++r) { o[0][r] = 0.f; o[1][r] = 0.f; }
#pragma unroll
            for (int k5 = 0; k5 < 5; ++k5) {
                if (k5 >= kt_lo) {
                    float p[16];
#pragma unroll
                    for (int r = 0; r < 16; ++r) { p[r] = __builtin_amdgcn_exp2f(sc[k5][r] - mx); lsum += p[r]; }
#pragma unroll
                    for (int s2 = 0; s2 < 2; ++s2) {
                        v4u t; t.x = cvtpk(p[8 * s2], p[8 * s2 + 1]); t.y = cvtpk(p[8 * s2 + 2], p[8 * s2 + 3]); t.z = cvtpk(p[8 * s2 + 4], p[8 * s2 + 5]); t.w = cvtpk(p[8 * s2 + 6], p[8 * s2 + 7]);
                        const bf16x8_t pa = __builtin_bit_cast(bf16x8_t, t);
                        const LAS unsigned char* vp = lds + L_V + (32 * (qt + k5) + 16 * s2 + 4 * hi + q4) * VST + (16 * blk + 4 * p4) * 2;
#pragma unroll
                        for (int d0 = 0; d0 < 2; ++d0) { const bf16x8_t vb = cat8(tr_read(vp + d0 * 64), tr_read(vp + d0 * 64 + 8 * VST)); o[d0] = MFMA32(pa, vb, o[d0]); }
                    }
                }
            }
            lsum += __shfl_xor(lsum, 32);
            lsum += __builtin_amdgcn_exp2f(sink2 - mx);
            if (hi == 0) wsf[r32] = 1.0f / lsum;
#pragma unroll
            for (int r = 0; r < 16; ++r) { const int qr = crow(r, hi); const float rl = wsf[qr];
                *(LAS unsigned short*)(ost + qr * 128 + r32 * 2) = (unsigned short)f2bf(o[0][r] * rl);
                *(LAS unsigned short*)(ost + qr * 128 + (32 + r32) * 2) = (unsigned short)f2bf(o[1][r] * rl); }
#pragma unroll
            for (int i = 0; i < 4; ++i) { const int id = lane + 64 * i, row = id >> 3, ch = id & 7;
                const v4u av = *(const LAS v4u*)(ost + row * 128 + ch * 16);
                const size_t tok = rowq + row; const int cb = hq * HD + ch * 8;
                const bf16* prow = F.PROJ + tok * PW + cb;
                const v4u ga = *(const v4u*)(prow + C_GA), gb = *(const v4u*)(prow + C_GB), gr = *(const v4u*)(prow + C_GR), gg = *(const v4u*)(gsrc + tok * gpitch + ch * 8);
                const f32x4 s0 = *(const f32x4*)(F.SSQG + tok * 32 + kvh * 8), s1 = *(const f32x4*)(F.SSQG + tok * 32 + kvh * 8 + 4);
                const float rg = 1.0f / sqrtf(((s0[0] + s0[1]) + (s0[2] + s0[3]) + (s1[0] + s1[1]) + (s1[2] + s1[3])) * (1.0f / GDV) + RMS_EPS);
                float res[8];
#pragma unroll
                for (int j = 0; j < 4; ++j) {
                    const float a0 = bflo(av[j]), a1 = bfhi(av[j]), x0 = bflo(gr[j]), x1 = bfhi(gr[j]);
                    const float l0 = bflo(gg[j]) * rg * gw8[2 * j] * (x0 * sigmoidf_(x0)), l1 = bfhi(gg[j]) * rg * gw8[2 * j + 1] * (x1 * sigmoidf_(x1));
                    res[2 * j] = sigmoidf_(bflo(ga[j])) * a0 + sigmoidf_(bflo(gb[j])) * l0;
                    res[2 * j + 1] = sigmoidf_(bfhi(ga[j])) * a1 + sigmoidf_(bfhi(gb[j])) * l1;
                }
                v4u ov; ov.x = cvtpk(res[0], res[1]); ov.y = cvtpk(res[2], res[3]); ov.z = cvtpk(res[4], res[5]); ov.w = cvtpk(res[6], res[7]);
                *(v4u*)(F.MERGED + tok * D + cb) = ov; }
        }
    }
    __syncthreads();
}

__device__ __forceinline__ void p7_final_norm(Frame& F) {
    const int gw = F.vcu * NWAVES + F.wave, NGW = F.G * NWAVES;
    f32x4 wv[8];
#pragma unroll
    for (int j = 0; j < 8; ++j) wv[j] = ((const f32x4*)F.fnorm_w)[F.lane + 64 * j];
    for (int m = gw; m < M; m += NGW) {
        float s = (F.lane < 32) ? F.SSQ3[(size_t)m * 32 + F.lane] : 0.f;
        s = wave_sum(s);
        const float rs = 1.0f / sqrtf(s * (1.0f / D) + RMS_EPS);
        GAS f32x4* xr = (GAS f32x4*)(F.out + (size_t)m * D) + F.lane;
#pragma unroll
        for (int j = 0; j < 8; ++j) { f32x4 v = xr[64 * j]; v = v * rs * wv[j]; xr[64 * j] = v; }
    }
}

struct Args { const float* in[13]; float* out; unsigned char* ws; int ph_lo, ph_hi; };
__global__ void __launch_bounds__(NTHREADS, 2) hybrid_fwd(Args args) {
    extern __shared__ __attribute__((aligned(16))) unsigned char lds[];
    Frame F;
    F.lds = (LAS unsigned char*)lds;
    F.MISC = (volatile LAS unsigned*)(F.lds + MISC_OFF);
    F.tid = threadIdx.x; F.lane = F.tid & 63; F.wave = __builtin_amdgcn_readfirstlane(F.tid >> 6);
    F.G = gridDim.x; { const int bx = blockIdx.x; F.vcu = (F.G % 8 == 0) ? (bx % 8) * (F.G / 8) + bx / 8 : bx; }
    unsigned char* ws = args.ws;
    F.ws = ws; F.ctl = (gu32*)(ws + WS_CTL);
    F.x = args.in[0]; F.norm1_w = args.in[1]; F.w_in = args.in[2]; F.gate_w2 = args.in[3]; F.gate_b = args.in[4]; F.sinks = args.in[5]; F.gnorm_w = args.in[6];
    F.w_out = args.in[7]; F.norm2_w = args.in[8]; F.w_gate = args.in[9]; F.w_up = args.in[10]; F.w_down = args.in[11]; F.fnorm_w = args.in[12];
    F.out = args.out;
    F.Win_t = (bf16*)(ws + WS_WIN); F.Wout_t = (bf16*)(ws + WS_WOUT); F.Wdown_t = (bf16*)(ws + WS_WDOWN); F.Wgu_t = (bf16*)((unsigned char*)args.out + OUT_WGU);
    F.XB = (bf16*)((unsigned char*)args.out + OUT_XB); F.MERGED = F.XB; F.PROJ = (bf16*)(ws + WS_PROJ); F.H1B = (bf16*)(ws + WS_H1B); F.FFB = (bf16*)(ws + WS_FF);
    F.RSTD1 = (float*)(ws + WS_RSTD1); F.GLR = (float*)(ws + WS_GLR); F.DEC = (float*)(ws + WS_DEC); F.SSQG = (float*)(ws + WS_SSQG); F.SSQ2 = (float*)(ws + WS_SSQ2); F.SSQ3 = (float*)(ws + WS_SSQ3);
    F.H1 = (float*)(ws + WS_H1);
    F.G012 = (bf16*)(ws + WS_WIN); F.G3 = (bf16*)((unsigned char*)args.out + OUT_G3);
    for (int u = F.tid; u < (LDS_BYTES - LDSCTL_OFF) / 4; u += NTHREADS) ((LAS unsigned*)(F.lds + LDSCTL_OFF))[u] = 0u;
    __syncthreads();
    XcdBarrier bar; bar.bar = (unsigned*)(F.ctl + CW_BAR); bar.x = 0; bar.st = nullptr;
    if (N_LAUNCHES == 1) bar = xcd_barrier_post((unsigned*)(F.ctl + CW_BAR), F.MISC + 8);
    const int lo = args.ph_lo, hi = args.ph_hi;
#define IN(k) (lo <= (k) && (k) < hi)
#ifndef REPEAT_PHASE
#define REPEAT_PHASE -1
#endif
#define REP(k) for (int rep_ = 0; rep_ < ((k) == REPEAT_PHASE ? 2 : 1); ++rep_)
#define SEAM(k) do { if (IN(k) && IN((k) + 1)) xcd_barrier(bar); } while (0)

    if (IN(0)) { REP(0) p0_prologue(F); SEAM(0); }
    if (IN(1)) {
        {
        pg8::Gemm g{F.XB, F.Win_t, M, NP1, D}; pg8::StaticOrder S; S.init(M, NP1, F.G, (int)blockIdx.x, REPEAT_PHASE == 1 ? 2 : 1);
        pg8::EpiProj E{F.PROJ, PW, F.RSTD1, F.GLR, PW / 256};
        pg8::gemm_phase<pg8::EpiProj, pg8::StaticOrder, true, true>(F.lds, g, S, E);
        }
        SEAM(1);
    }
#if GLA_OPT
    if (IN(2)) { p2a_gla_prep(F); SEAM(2); }
    if (IN(3)) { REP(3) p2b_gla_main(F); SEAM(3); }
#else
    if (IN(2)) { SEAM(2); }
    if (IN(3)) { p2_gla_naive(F); SEAM(3); }
#endif
#if ATT_OPT
    if (IN(4)) { REP(4) p3_attn(F); SEAM(4); }
#else
    if (IN(4)) { p3_attn_naive(F); SEAM(4); }
#endif
    if (IN(5)) {
        {
        pg8::Gemm g{F.MERGED, F.Wout_t, M, D, D}; pg8::StaticOrder S; S.init(M, D, F.G, (int)blockIdx.x, REPEAT_PHASE == 5 ? 2 : 1);
        pg8::EpiRes E{F.x, F.H1, F.H1B, D, F.SSQ2};
        pg8::gemm_phase<pg8::EpiRes, pg8::StaticOrder, true, true>(F.lds, g, S, E);
        }
        SEAM(5);
    }
    if (IN(6)) {
        {
        pg8::Gemm g{F.H1B, F.Wgu_t, M, 2 * FF, D}; pg8::StaticOrder S; S.init(M, 2 * FF, F.G, (int)blockIdx.x, REPEAT_PHASE == 6 ? 2 : 1);
        pg8::EpiSwiGLU E{F.FFB, FF, F.SSQ2, 1.0f / D};
        pg8::gemm_phase<pg8::EpiSwiGLU, pg8::StaticOrder, true, true>(F.lds, g, S, E);
        }
        SEAM(6);
    }
    if (IN(7)) {
        {
        pg8::Gemm g{F.FFB, F.Wdown_t, M, D, FF}; pg8::StaticOrder S; S.init(M, D, F.G, (int)blockIdx.x, REPEAT_PHASE == 7 ? 2 : 1);
        pg8::EpiRes E{F.H1, F.out, nullptr, D, F.SSQ3};
        pg8::gemm_phase<pg8::EpiRes, pg8::StaticOrder, true, true>(F.lds, g, S, E);
        }
        SEAM(7);
    }
    if (IN(8)) { p7_final_norm(F); }
#undef IN
#undef SEAM
}

extern "C" void kernel_launch(void* const* d_in, const int* in_sizes, int n_in, void* d_out, int out_size, void* d_ws, size_t ws_size, hipStream_t stream) {
    static int grid = 0;
    if (grid == 0) {
        if (n_in != 13 || in_sizes[0] != M * D || out_size != M * D || ws_size < WS_END) { fprintf(stderr, "kernel_launch: unexpected shapes (n_in %d, in0 %d, out %d, ws %zu)\n", n_in, n_in > 0 ? in_sizes[0] : -1, out_size, ws_size); grid = -1; return; }
        int dev = 0, cus = 0, per_cu = 0;
        if (hipGetDevice(&dev) != hipSuccess || hipDeviceGetAttribute(&cus, hipDeviceAttributeMultiprocessorCount, dev) != hipSuccess) { grid = -1; return; }
        if (hipFuncSetAttribute((const void*)hybrid_fwd, hipFuncAttributeMaxDynamicSharedMemorySize, LDS_BYTES) != hipSuccess) { fprintf(stderr, "kernel_launch: hipFuncSetAttribute failed\n"); grid = -1; return; }
        if (hipOccupancyMaxActiveBlocksPerMultiprocessor(&per_cu, (const void*)hybrid_fwd, NTHREADS, LDS_BYTES) != hipSuccess || per_cu < 1) { fprintf(stderr, "kernel_launch: occupancy query reports %d\n", per_cu); }
        (void)hipGetLastError();
        grid = cus;
    }
    if (grid < 0) return;
    (void)hipMemsetAsync((char*)d_ws + WS_CTL, 0, CTL_ZERO_BYTES, stream);
    Args a{};
    for (int i = 0; i < 13; ++i) a.in[i] = (const float*)d_in[i];
    a.out = (float*)d_out; a.ws = (unsigned char*)d_ws;
    if (N_LAUNCHES == 1) { a.ph_lo = 0; a.ph_hi = N_PHASES; hipLaunchKernelGGL(hybrid_fwd, dim3(grid), dim3(NTHREADS), LDS_BYTES, stream, a); }
    else for (int li = 0; li < N_PHASES; ++li) { a.ph_lo = li; a.ph_hi = li + 1; hipLaunchKernelGGL(hybrid_fwd, dim3(grid), dim3(NTHREADS), LDS_BYTES, stream, a); }
}
```

```cpp
#include <hip/hip_runtime.h>
#include <cstdio>
#include <cstdint>

#ifndef MK_N_LAUNCHES
#define MK_N_LAUNCHES 1
#endif

namespace pg8 {
#define PG8_LAS __attribute__((address_space(3)))
typedef unsigned short bf16_t;
typedef short bf16x8 __attribute__((ext_vector_type(8)));
typedef float f32x4 __attribute__((ext_vector_type(4)));
typedef unsigned u32x4 __attribute__((ext_vector_type(4)));
constexpr int BM = 256, BK = 64, HALF = 128, HTB = HALF * BK * 2  , STAGE_BYTES = 8 * HTB, NXCD = 8, WGM = 8;

__host__ __device__ __forceinline__ int lds_byte(int r, int c) { const int st = (r >> 4) * 2 + (c >> 5), rr = r & 15, cc = c & 31, ob = rr * 64 + cc * 2; return st * 1024 + (ob ^ (((ob >> 9) & 1) << 5)); }
__host__ __device__ __forceinline__ void stage_rc(int b, int& R, int& C) { const int st = b / 1024, sb = b % 1024, swz = sb ^ (((sb >> 9) & 1) << 5); R = (st >> 1) * 16 + swz / 64; C = (st & 1) * 32 + (swz % 64) / 2; }
__host__ __device__ __forceinline__ int perm32(int rho) { const int n = rho >> 4, i = rho & 15; return 8 * (i >> 2) + 4 * n + (i & 3); }

struct Unit { int pm, pn; };
struct Gemm { const bf16_t* A; const bf16_t* Bt; int M, N, K; };

struct StaticOrder {
    int nM, nN, nwg, G, c, rep;
    __host__ __device__ void init(int M, int N, int G_, int c_, int rep_ = 1) { nM = M / BM; nN = N / BM; nwg = nM * nN; G = G_; c = c_; rep = rep_; }
    __host__ __device__ bool next(int i, Unit& u) const {
        const long L = (long)i * G + c; if (L >= (long)nwg * rep) return false;
        int wgid = (int)(L % nwg); { const int q = nwg / NXCD, r = nwg % NXCD, xcd = wgid % NXCD, off = wgid / NXCD; wgid = (xcd < r ? xcd * (q + 1) : r * (q + 1) + (xcd - r) * q) + off; }
        const int nig = WGM * nN, gid = wgid / nig, fm = gid * WGM, gsz = (nM - fm) < WGM ? (nM - fm) : WGM;
        u.pm = fm + ((wgid % nig) % gsz); u.pn = (wgid % nig) / gsz; return true;
    }
    __device__ __forceinline__ void a_ready(const Unit&) const {}
    __device__ __forceinline__ void done(const Unit&) const {}
};

__device__ __forceinline__ unsigned cvt_pk_bf16(float lo, float hi) { unsigned r; asm volatile("v_cvt_pk_bf16_f32 %0, %1, %2" : "=v"(r) : "v"(lo), "v"(hi)); return r; }
__device__ __forceinline__ float sum4(const f32x4 v) { return (v[0] + v[1]) + (v[2] + v[3]); }
__device__ __forceinline__ float sq4(const f32x4 v) { return (v[0] * v[0] + v[1] * v[1]) + (v[2] * v[2] + v[3] * v[3]); }
constexpr float RMS_EPS = 1e-6f;

struct EpiProj {
    static constexpr bool PERM = true, AFTER_DRAIN = false;
    bf16_t* O; int ldc; const float* rstd; float* glr; int glr_tile;
    __device__ __forceinline__ void operator()(const f32x4 (&acc)[2][2][4][2], const Unit& u, int wr, int wc, int fr, int fq) const {
        const int row0 = u.pm * BM + wr * 64 + fr;
        if (u.pn == glr_tile) {
            if (wc == 0 && fq < 2) {
#pragma unroll
                for (int ai = 0; ai < 2; ++ai)
#pragma unroll
                    for (int m = 0; m < 4; ++m) { const int row = row0 + ai * HALF + m * 16; const float s = rstd[row]; float* p = glr + (size_t)row * 16 + 8 * fq;
                        *(f32x4*)p = acc[ai][0][m][0] * s; *(f32x4*)(p + 4) = acc[ai][0][m][1] * s; }
            }
            return;
        }
        float rs[2][4];
#pragma unroll
        for (int ai = 0; ai < 2; ++ai)
#pragma unroll
            for (int m = 0; m < 4; ++m) rs[ai][m] = rstd[row0 + ai * HALF + m * 16];
        const int col0 = u.pn * BM + wc * 64 + 8 * fq;
#pragma unroll
        for (int ai = 0; ai < 2; ++ai)
#pragma unroll
            for (int m = 0; m < 4; ++m) { bf16_t* rowp = O + (size_t)(row0 + ai * HALF + m * 16) * ldc + col0; const float s = rs[ai][m];
#pragma unroll
                for (int bj = 0; bj < 2; ++bj) { const f32x4 v0 = acc[ai][bj][m][0] * s, v1 = acc[ai][bj][m][1] * s;
                    u32x4 w; w.x = cvt_pk_bf16(v0[0], v0[1]); w.y = cvt_pk_bf16(v0[2], v0[3]); w.z = cvt_pk_bf16(v1[0], v1[1]); w.w = cvt_pk_bf16(v1[2], v1[3]);
                    *(u32x4*)(rowp + bj * 32) = w; } }
    }
};
struct EpiRes1 {
    static constexpr bool PERM = true, AFTER_DRAIN = false;
    const float* base; bf16_t* outb; int ldc; float* ssq;
    __device__ __forceinline__ void operator()(const f32x4 (&acc)[2][2][4][2], const Unit& u, int wr, int wc, int fr, int fq) const {
        const int row0 = u.pm * BM + wr * 64 + fr, col0 = u.pn * BM + wc * 64 + 8 * fq;
#pragma unroll
        for (int ai = 0; ai < 2; ++ai)
#pragma unroll
            for (int m = 0; m < 4; ++m) { const int row = row0 + ai * HALF + m * 16; const size_t off = (size_t)row * ldc + col0; float s = 0.f;
#pragma unroll
                for (int bj = 0; bj < 2; ++bj) { const f32x4 b0 = *(const f32x4*)(base + off + bj * 32), b1 = *(const f32x4*)(base + off + bj * 32 + 4);
                    const f32x4 v0 = acc[ai][bj][m][0] + b0, v1 = acc[ai][bj][m][1] + b1;
                    u32x4 w; w.x = cvt_pk_bf16(v0[0], v0[1]); w.y = cvt_pk_bf16(v0[2], v0[3]); w.z = cvt_pk_bf16(v1[0], v1[1]); w.w = cvt_pk_bf16(v1[2], v1[3]); *(u32x4*)(outb + off + bj * 32) = w;
                    s += sq4(v0) + sq4(v1); }
                s += __shfl_xor(s, 16); s += __shfl_xor(s, 32);
                if (fq == 0) ssq[(size_t)row * 32 + u.pn * 4 + wc] = s; }
    }
};
struct EpiRes2 {
    static constexpr bool PERM = true, AFTER_DRAIN = false;
    const bf16_t* base; float* out; int ldc; float* ssq;
    __device__ __forceinline__ void operator()(const f32x4 (&acc)[2][2][4][2], const Unit& u, int wr, int wc, int fr, int fq) const {
        const int row0 = u.pm * BM + wr * 64 + fr, col0 = u.pn * BM + wc * 64 + 8 * fq;
#pragma unroll
        for (int ai = 0; ai < 2; ++ai)
#pragma unroll
            for (int m = 0; m < 4; ++m) { const int row = row0 + ai * HALF + m * 16; const size_t off = (size_t)row * ldc + col0; float s = 0.f;
#pragma unroll
                for (int bj = 0; bj < 2; ++bj) { const u32x4 bw = *(const u32x4*)(base + off + bj * 32);
                    f32x4 b0, b1; b0[0] = __builtin_bit_cast(float, bw.x << 16); b0[1] = __builtin_bit_cast(float, bw.x & 0xffff0000u); b0[2] = __builtin_bit_cast(float, bw.y << 16); b0[3] = __builtin_bit_cast(float, bw.y & 0xffff0000u);
                    b1[0] = __builtin_bit_cast(float, bw.z << 16); b1[1] = __builtin_bit_cast(float, bw.z & 0xffff0000u); b1[2] = __builtin_bit_cast(float, bw.w << 16); b1[3] = __builtin_bit_cast(float, bw.w & 0xffff0000u);
                    const f32x4 v0 = acc[ai][bj][m][0] + b0, v1 = acc[ai][bj][m][1] + b1;
                    *(f32x4*)(out + off + bj * 32) = v0; *(f32x4*)(out + off + bj * 32 + 4) = v1;
                    s += sq4(v0) + sq4(v1); }
                s += __shfl_xor(s, 16); s += __shfl_xor(s, 32);
                if (fq == 0) ssq[(size_t)row * 32 + u.pn * 4 + wc] = s; }
    }
};
struct EpiSwiGLU {
    static constexpr bool PERM = true, AFTER_DRAIN = false;
    bf16_t* ff; int ldc; const float* ssq; float inv_n;
    __device__ __forceinline__ void operator()(const f32x4 (&acc)[2][2][4][2], const Unit& u, int wr, int wc, int fr, int fq) const {
        const int row0 = u.pm * BM + wr * 64 + fr, col0 = u.pn * HALF + wc * 32 + 8 * fq;
#pragma unroll
        for (int ai = 0; ai < 2; ++ai)
#pragma unroll
            for (int m = 0; m < 4; ++m) { const int row = row0 + ai * HALF + m * 16;
                const f32x4* sp = (const f32x4*)(ssq + (size_t)row * 32 + fq * 8); float s = sum4(sp[0]) + sum4(sp[1]);
                s += __shfl_xor(s, 16); s += __shfl_xor(s, 32);
                const float rs = 1.0f / sqrtf(s * inv_n + RMS_EPS);
                float f[8];
#pragma unroll
                for (int n = 0; n < 2; ++n)
#pragma unroll
                    for (int i = 0; i < 4; ++i) { const float g = acc[ai][0][m][n][i] * rs, up = acc[ai][1][m][n][i] * rs;
                        f[4 * n + i] = g * __builtin_amdgcn_rcpf(1.0f + __builtin_amdgcn_exp2f(-1.4426950408889634f * g)) * up; }
                u32x4 w; w.x = cvt_pk_bf16(f[0], f[1]); w.y = cvt_pk_bf16(f[2], f[3]); w.z = cvt_pk_bf16(f[4], f[5]); w.w = cvt_pk_bf16(f[6], f[7]);
                *(u32x4*)(ff + (size_t)row * ldc + col0) = w; }
    }
};

template <class Epi, class Sched, bool ALIGN_EPI = false, bool SP2 = false>
__device__ __forceinline__ void gemm_phase(PG8_LAS unsigned char* lds, const Gemm g, const Sched& S, const Epi& E) {
    const int tid = threadIdx.x, wid = __builtin_amdgcn_readfirstlane(tid >> 6), lane = tid & 63, wr = wid >> 2, wc = wid & 3, fr = lane & 15, fq = lane >> 4;
    const int K = g.K, nt = K / BK;
    unsigned voffA[2], voffB[2], voffB1[2];
#pragma unroll
    for (int i = 0; i < 2; ++i) { int R, C; stage_rc(tid * 16 + i * 8192, R, C); const int Rb = (R >> 5) * 64 + perm32(R & 31);
        voffA[i] = (unsigned)(R * K + C) * 2u; voffB[i] = (unsigned)(Rb * K + C) * 2u; voffB1[i] = (unsigned)((Rb + 32) * K + C) * 2u; }
    const size_t kstep = (size_t)(BK * 2);
    const size_t hstep = (size_t)HALF * K * 2;
    const size_t tstep = 2 * hstep;
    const unsigned ldsw = (unsigned)wid * 1024u;
    const int aoff = lds_byte(wr * 64 + fr, fq * 8), boff = lds_byte(wc * 32 + fr, fq * 8);
#define PG8_SA(b, h) (((b) * 2 + (h)) * HTB)
#define PG8_SB(b, h) ((4 + (b) * 2 + (h)) * HTB)
#define PG8_STAGE(bufoff, gbase, voff) do { _Pragma("unroll") for (int _i = 0; _i < 2; ++_i) \
        __builtin_amdgcn_global_load_lds((const unsigned*)((const char*)(gbase) + (voff)[_i]), (PG8_LAS unsigned*)(lds + (bufoff) + ldsw + _i * 8192), 16, 0, 0); } while (0)
#define PG8_LDA(dst, b, h) do { _Pragma("unroll") for (int m = 0; m < 4; ++m) _Pragma("unroll") for (int k = 0; k < 2; ++k) dst[m][k] = *(const PG8_LAS bf16x8*)(lds + PG8_SA(b, h) + aoff + m * 2048 + k * 1024); } while (0)
#define PG8_LDB(dst, b, h) do { _Pragma("unroll") for (int n = 0; n < 2; ++n) _Pragma("unroll") for (int k = 0; k < 2; ++k) dst[n][k] = *(const PG8_LAS bf16x8*)(lds + PG8_SB(b, h) + boff + n * 2048 + k * 1024); } while (0)
#define PG8_MMA(ai, bj, At, Bt) do { __builtin_amdgcn_s_setprio(1); _Pragma("unroll") for (int m = 0; m < 4; ++m) _Pragma("unroll") for (int n = 0; n < 2; ++n) _Pragma("unroll") for (int k = 0; k < 2; ++k) \
        acc[ai][bj][m][n] = __builtin_amdgcn_mfma_f32_16x16x32_bf16(Bt[n][k], At[m][k], acc[ai][bj][m][n], 0, 0, 0); __builtin_amdgcn_s_setprio(0); } while (0)
#define PG8_WAIT_V(n) asm volatile("s_waitcnt vmcnt(" #n ")" ::: "memory")
#define PG8_WAIT_L(n) asm volatile("s_waitcnt lgkmcnt(" #n ")" ::: "memory")
#define PG8_BAR __builtin_amdgcn_s_barrier()
#define PG8_SCHED __builtin_amdgcn_sched_barrier(0)
    Unit cur, nxt; int ui = 0;
    if (!S.next(0, cur)) return;
    f32x4 acc[2][2][4][2];
#pragma unroll
    for (int a = 0; a < 2; ++a)
#pragma unroll
        for (int b = 0; b < 2; ++b)
#pragma unroll
            for (int m = 0; m < 4; ++m)
#pragma unroll
                for (int n = 0; n < 2; ++n) acc[a][b][m][n] = (f32x4){0.f, 0.f, 0.f, 0.f};
    bf16x8 At[4][2], B0[2][2], B1[2][2];
    const char* cA = (const char*)g.A + (size_t)cur.pm * tstep; const char* cB = (const char*)g.Bt + (size_t)cur.pn * tstep;
    S.a_ready(cur);
    if constexpr (SP2) {
        PG8_STAGE(PG8_SB(0, 0), cB, voffB); PG8_STAGE(PG8_SB(0, 1), cB, voffB1); PG8_STAGE(PG8_SA(0, 0), cA, voffA); PG8_STAGE(PG8_SA(0, 1), cA + hstep, voffA);
        if (wr == 1) PG8_BAR;
        PG8_WAIT_V(2); PG8_BAR;
        PG8_STAGE(PG8_SB(1, 0), cB + kstep, voffB); PG8_STAGE(PG8_SA(1, 0), cA + kstep, voffA); PG8_STAGE(PG8_SB(1, 1), cB + kstep, voffB1);
        PG8_WAIT_V(6); PG8_BAR;
    } else {
        PG8_STAGE(PG8_SB(0, 0), cB, voffB); PG8_STAGE(PG8_SA(0, 0), cA, voffA); PG8_STAGE(PG8_SB(0, 1), cB, voffB1); PG8_STAGE(PG8_SA(0, 1), cA + hstep, voffA);
        if (wr == 1) PG8_BAR;
        PG8_WAIT_V(4); PG8_BAR;
        PG8_STAGE(PG8_SB(1, 0), cB + kstep, voffB); PG8_STAGE(PG8_SA(1, 0), cA + kstep, voffA); PG8_STAGE(PG8_SB(1, 1), cB + kstep, voffB1);
        PG8_WAIT_V(6); PG8_BAR;
    }
    for (;;) {
        const bool has_next = S.next(ui + 1, nxt);
        const char* nA = has_next ? (const char*)g.A + (size_t)nxt.pm * tstep : cA; const char* nB = has_next ? (const char*)g.Bt + (size_t)nxt.pn * tstep : cB;
        for (int t = 0; t < nt; t += 2) {
            const bool last = (t == nt - 2);
            const char* a1 = cA + (size_t)(t + 1) * kstep;
            const char* a2 = last ? nA : cA + (size_t)(t + 2) * kstep; const char* b2 = last ? nB : cB + (size_t)(t + 2) * kstep;
            const char* a3 = a2 + kstep; const char* b3 = b2 + kstep;
            if (last && has_next) S.a_ready(nxt);
            if constexpr (SP2) {
            PG8_LDB(B0, 0, 0); PG8_LDB(B1, 0, 1); PG8_SCHED; PG8_LDA(At, 0, 0); PG8_STAGE(PG8_SA(1, 1), a1 + hstep, voffA);
            PG8_WAIT_V(8); PG8_WAIT_L(0); PG8_BAR; PG8_MMA(0, 0, At, B0); PG8_MMA(0, 1, At, B1); PG8_BAR; PG8_SCHED;
            PG8_LDA(At, 0, 1); PG8_STAGE(PG8_SB(0, 0), b2, voffB); PG8_STAGE(PG8_SB(0, 1), b2, voffB1); PG8_STAGE(PG8_SA(0, 0), a2, voffA);
            PG8_WAIT_V(8); PG8_WAIT_L(0); PG8_BAR; PG8_MMA(1, 0, At, B0); PG8_MMA(1, 1, At, B1); PG8_BAR; PG8_SCHED;
            PG8_LDB(B0, 1, 0); PG8_LDB(B1, 1, 1); PG8_SCHED; PG8_LDA(At, 1, 0); PG8_STAGE(PG8_SA(0, 1), a2 + hstep, voffA);
            PG8_WAIT_V(8); PG8_WAIT_L(0); PG8_BAR; PG8_MMA(0, 0, At, B0); PG8_MMA(0, 1, At, B1); PG8_BAR; PG8_SCHED;
            PG8_LDA(At, 1, 1); PG8_STAGE(PG8_SB(1, 0), b3, voffB); PG8_STAGE(PG8_SB(1, 1), b3, voffB1); PG8_STAGE(PG8_SA(1, 0), a3, voffA);
            PG8_WAIT_V(8); PG8_WAIT_L(0); PG8_BAR; PG8_MMA(1, 0, At, B0); PG8_MMA(1, 1, At, B1); PG8_BAR; PG8_SCHED;
            } else {
            PG8_LDB(B0, 0, 0); PG8_SCHED; PG8_LDA(At, 0, 0); PG8_STAGE(PG8_SA(1, 1), a1 + hstep, voffA);
            PG8_WAIT_L(8); PG8_BAR; PG8_WAIT_L(0); PG8_MMA(0, 0, At, B0); PG8_BAR; PG8_SCHED;
            PG8_LDB(B1, 0, 1); PG8_STAGE(PG8_SB(0, 0), b2, voffB);
            PG8_BAR; PG8_WAIT_L(0); PG8_MMA(0, 1, At, B1); PG8_BAR;
            PG8_LDA(At, 0, 1); PG8_STAGE(PG8_SA(0, 0), a2, voffA);
            PG8_BAR; PG8_WAIT_L(0); PG8_MMA(1, 0, At, B0); PG8_BAR; PG8_SCHED;
            PG8_STAGE(PG8_SB(0, 1), b2, voffB1);
            PG8_WAIT_V(6); PG8_BAR; PG8_MMA(1, 1, At, B1); PG8_BAR;
            PG8_LDB(B0, 1, 0); PG8_SCHED; PG8_LDA(At, 1, 0); PG8_STAGE(PG8_SA(0, 1), a2 + hstep, voffA);
            PG8_WAIT_L(8); PG8_BAR; PG8_WAIT_L(0); PG8_MMA(0, 0, At, B0); PG8_BAR; PG8_SCHED;
            PG8_LDB(B1, 1, 1); PG8_STAGE(PG8_SB(1, 0), b3, voffB);
            PG8_BAR; PG8_WAIT_L(0); PG8_MMA(0, 1, At, B1); PG8_BAR;
            PG8_LDA(At, 1, 1); PG8_STAGE(PG8_SA(1, 0), a3, voffA);
            PG8_BAR; PG8_WAIT_L(0); PG8_MMA(1, 0, At, B0); PG8_BAR; PG8_SCHED;
            PG8_STAGE(PG8_SB(1, 1), b3, voffB1);
            PG8_WAIT_V(6); PG8_BAR; PG8_MMA(1, 1, At, B1); PG8_BAR;
            }
        }
        if constexpr (ALIGN_EPI) { if (wr == 0) PG8_BAR; }
        if constexpr (!Epi::AFTER_DRAIN) { E(acc, cur, wr, wc, fr, fq);
#if defined(EPI_TWICE)
            asm volatile("" ::: "memory"); E(acc, cur, wr, wc, fr, fq);
#endif
            S.done(cur); }
        if (!has_next) break;
#pragma unroll
        for (int a = 0; a < 2; ++a)
#pragma unroll
            for (int b = 0; b < 2; ++b)
#pragma unroll
                for (int m = 0; m < 4; ++m)
#pragma unroll
                    for (int n = 0; n < 2; ++n) acc[a][b][m][n] = (f32x4){0.f, 0.f, 0.f, 0.f};
        cur = nxt; cA = nA; cB = nB; ++ui;
        if constexpr (ALIGN_EPI) { if (wr == 1) PG8_BAR; }
    }
    PG8_WAIT_V(0);
    if constexpr (!ALIGN_EPI) { if (wr == 0) PG8_BAR; }
    PG8_BAR;
    if constexpr (Epi::AFTER_DRAIN) { E.fused(acc, cur, wr, wc, fr, fq, lds, wid, lane); S.done(cur); }
#undef PG8_SA
#undef PG8_SB
#undef PG8_STAGE
#undef PG8_LDA
#undef PG8_LDB
#undef PG8_MMA
#undef PG8_WAIT_V
#undef PG8_WAIT_L
#undef PG8_BAR
#undef PG8_SCHED
}
}

#ifndef GLA_OPT
#define GLA_OPT 1
#endif
#ifndef ATT_OPT
#define ATT_OPT 1
#endif
constexpr int NWAVES = 8, NTHREADS = NWAVES * 64;
constexpr int N_LAUNCHES = MK_N_LAUNCHES;
constexpr int N_PHASES = 9;
constexpr int BATCH = 8, SEQ = 2048, D = 2048, M = BATCH * SEQ;
constexpr int HD = 64, NQH = 32, NKVH = 4, GQA = 8, WIN = 128;
constexpr int GH = 4, GDK = 256, GDV = 512, GRANK = 16, GCHUNK = 64;
constexpr int FF = 5632;
constexpr int DIN = 12816;
constexpr int PW = 12800;
constexpr int NP1 = 13056;
constexpr int C_AQ = 0, C_AK = 2048, C_AV = 2304, C_GQ = 2560, C_GK = 3584, C_GV = 4608, C_GR = 6656, C_GA = 8704, C_GB = 10752;
constexpr int SRC_GLR = 6656;
constexpr float RMS_EPS = 1e-6f;

constexpr size_t MiB = 1u << 20;
constexpr size_t WS_CTL = 0, CTL_ZERO_BYTES = 64 * 1024;
constexpr size_t WS_RSTD1 = 1 * MiB;
constexpr size_t WS_GLR = 2 * MiB;
constexpr size_t WS_DEC = 3 * MiB;
constexpr size_t WS_SSQG = 4 * MiB;
constexpr size_t WS_SSQ2 = 6 * MiB;
constexpr size_t WS_SSQ3 = 8 * MiB;
constexpr size_t WS_WOUT = 10 * MiB;
constexpr size_t WS_WDOWN = 18 * MiB;
constexpr size_t WS_WIN = 40 * MiB;
constexpr size_t WS_PROJ = 92 * MiB;
constexpr size_t WS_H1 = WS_PROJ;
constexpr size_t WS_H1B = WS_PROJ + 128 * MiB;
constexpr size_t WS_FF = WS_PROJ + 192 * MiB;
constexpr size_t WS_END = 492 * MiB;
static_assert(WS_WIN + (size_t)NP1 * D * 2 <= WS_PROJ && WS_PROJ + (size_t)M * PW * 2 <= WS_END && WS_FF + (size_t)M * FF * 2 <= WS_END && WS_WDOWN + (size_t)D * FF * 2 <= WS_WIN, "ws map");
constexpr size_t OUT_XB = 0;
constexpr size_t OUT_G3 = 108 * MiB;
constexpr size_t OUT_WGU = 64 * MiB;
constexpr int CW_BAR = 1024;

constexpr int RING_BYTES = 131072, LDSCTL_OFF = RING_BYTES, MISC_OFF = LDSCTL_OFF + 320, LDS_BYTES = 147456;

#define GAS __attribute__((address_space(1)))
#define LAS __attribute__((address_space(3)))
typedef unsigned short bf16;
typedef unsigned v4u __attribute__((ext_vector_type(4)));
typedef unsigned v2u __attribute__((ext_vector_type(2)));
typedef float f32x4 __attribute__((ext_vector_type(4)));
typedef GAS unsigned gu32;
#define LDS_WAIT() asm volatile("s_waitcnt lgkmcnt(0)" ::: "memory")
#define VM_WAIT() asm volatile("s_waitcnt vmcnt(0)" ::: "memory")
__device__ __forceinline__ unsigned f2bf(float f) { unsigned u = __builtin_bit_cast(unsigned, f); return (u + 0x7fffu + ((u >> 16) & 1u)) >> 16; }
__device__ __forceinline__ unsigned pk2(float lo, float hi) { return f2bf(lo) | (f2bf(hi) << 16); }
__device__ __forceinline__ float bf2f(unsigned short b) { return __builtin_bit_cast(float, (unsigned)b << 16); }
__device__ __forceinline__ float bflo(unsigned w) { return __builtin_bit_cast(float, w << 16); }
__device__ __forceinline__ float bfhi(unsigned w) { return __builtin_bit_cast(float, w & 0xffff0000u); }
__device__ __forceinline__ float sigmoidf_(float x) { return 1.0f / (1.0f + __expf(-x)); }

#define XB_TMO      128
#define XB_XCNT(j)  (256  + 64 * (j))
#define XB_XSUB(j)  (1280 + 64 * (j))
#define XB_XGEN(j)  (2304 + 64 * (j))
#define XB_TOP      3328
#define XB_TOPGEN   3392
#define XCD_BAR_WORDS 3456
#define XB_SPIN_CAP (1u << 22)
static_assert((CW_BAR + XCD_BAR_WORDS) * 4 <= (int)CTL_ZERO_BYTES, "barrier words inside the memset region");

__device__ __forceinline__ unsigned xb_ld(unsigned* p)              { return __hip_atomic_load(p, __ATOMIC_RELAXED, __HIP_MEMORY_SCOPE_AGENT); }
__device__ __forceinline__ unsigned xb_add(unsigned* p, unsigned v) { return __hip_atomic_fetch_add(p, v, __ATOMIC_RELAXED, __HIP_MEMORY_SCOPE_AGENT); }
__device__ __forceinline__ unsigned xb_xcc_id() { return (unsigned)__builtin_amdgcn_s_getreg((3 << 11) | 20) & 0xFu; }
#define XB_SPIN(cond, bar) do { unsigned _sp = 0; while (cond) { __builtin_amdgcn_s_sleep(1); \
    if ((++_sp & 255u) == 0u) { if (xb_ld(&(bar)[XB_TMO])) break; if (_sp > XB_SPIN_CAP) { atomicAdd(&(bar)[XB_TMO], 1u); break; } } } } while (0)

struct XcdBarrier { unsigned* bar; unsigned x; volatile LAS unsigned* st; };

__device__ __forceinline__ XcdBarrier xcd_barrier_post(unsigned* bar, volatile LAS unsigned* st) {
    XcdBarrier b; b.bar = bar; b.x = xb_xcc_id(); b.st = st;
    if (threadIdx.x == 0) (void)xb_add(&bar[XB_XCNT(b.x)], 1u);
    return b;
}
__device__ __forceinline__ void xcd_barrier_complete(unsigned* bar, unsigned x, unsigned& nloc, unsigned& nx) {
    const unsigned G = gridDim.x * gridDim.y * gridDim.z;
    unsigned sum, cnt, mine, sp = 0u;
    for (;;) {
        sum = 0u; cnt = 0u; mine = 0u;
#pragma unroll
        for (unsigned j = 0; j < 16; ++j) { const unsigned c = xb_ld(&bar[XB_XCNT(j)]); sum += c; cnt += (c > 0u) ? 1u : 0u; mine = (j == x) ? c : mine; }
        if (sum == G) break;
        __builtin_amdgcn_s_sleep(1);
        if ((++sp & 255u) == 0u) { if (xb_ld(&bar[XB_TMO])) break; if (sp > XB_SPIN_CAP) { atomicAdd(&bar[XB_TMO], 1u); break; } }
    }
    nloc = mine > 0u ? mine : 1u; nx = cnt > 0u ? cnt : 1u;
}
__device__ __forceinline__ void xcd_barrier(const XcdBarrier& b) {
    asm volatile("s_waitcnt vmcnt(0)" ::: "memory");
    __syncthreads();
    if (threadIdx.x == 0) {
        unsigned* bar = b.bar;
        __builtin_amdgcn_s_waitcnt(0);
        unsigned nloc = b.st[0], nx = b.st[1];
        if (nloc == 0u) { xcd_barrier_complete(bar, b.x, nloc, nx); b.st[0] = nloc; b.st[1] = nx; }
        const unsigned old = xb_add(&bar[XB_XSUB(b.x)], 1u);
        const unsigned gen = old / nloc;
        if (old + 1u == (gen + 1u) * nloc) {
            __builtin_amdgcn_fence(__ATOMIC_RELEASE, "agent");
            asm volatile("s_waitcnt vmcnt(0)" ::: "memory");
            const unsigned og = xb_add(&bar[XB_TOP], 1u);
            const unsigned tg = og / nx;
            if (og + 1u == (tg + 1u) * nx) xb_add(&bar[XB_TOPGEN], 1u);
            else XB_SPIN(xb_ld(&bar[XB_TOPGEN]) == tg, bar);
            __builtin_amdgcn_fence(__ATOMIC_ACQUIRE, "agent");
            xb_add(&bar[XB_XGEN(b.x)], 1u);
            asm volatile("s_waitcnt vmcnt(0)" ::: "memory");
        } else {
            XB_SPIN(xb_ld(&bar[XB_XGEN(b.x)]) == gen, bar);
            __builtin_amdgcn_fence(__ATOMIC_ACQUIRE, "agent");
            asm volatile("s_waitcnt vmcnt(0)" ::: "memory");
        }
    }
    __syncthreads();
}

struct Frame {
    LAS unsigned char* lds;
    volatile LAS unsigned* MISC;
    gu32* ctl;
    int tid, lane, wave, vcu, G;
    const float *x, *norm1_w, *w_in, *gate_w2, *gate_b, *sinks, *gnorm_w, *w_out, *norm2_w, *w_gate, *w_up, *w_down, *fnorm_w;
    float* out;
    unsigned char* ws;
    bf16 *Win_t, *Wout_t, *Wgu_t, *Wdown_t, *XB, *PROJ, *MERGED, *H1B, *FFB;
    float *RSTD1, *GLR, *DEC, *SSQG, *SSQ2, *SSQ3, *H1;
    bf16 *G012, *G3;
};

__device__ __forceinline__ float wave_sum(float v) {
#pragma unroll
    for (int o = 1; o < 64; o <<= 1) v += __shfl_xor(v, o);
    return v;
}

typedef short bf16x8_t __attribute__((ext_vector_type(8)));
typedef short s16x4_t __attribute__((ext_vector_type(4)));
typedef float f32x16 __attribute__((ext_vector_type(16)));
__device__ __forceinline__ unsigned cvtpk(float lo, float hi) { typedef float f2 __attribute__((ext_vector_type(2))); typedef __bf16 b2 __attribute__((ext_vector_type(2)));
    f2 v = {lo, hi}; b2 b = __builtin_convertvector(v, b2); return __builtin_bit_cast(unsigned, b); }
__device__ __forceinline__ s16x4_t tr_read(LAS const unsigned char* p) { return __builtin_bit_cast(s16x4_t, __builtin_amdgcn_ds_read_tr16_b64_v4i16((LAS s16x4_t*)p)); }
__device__ __forceinline__ bf16x8_t cat8(s16x4_t lo, s16x4_t hi) { return __builtin_shufflevector(lo, hi, 0, 1, 2, 3, 4, 5, 6, 7); }
#define MFMA16(a, b, c) __builtin_amdgcn_mfma_f32_16x16x32_bf16((a), (b), (c), 0, 0, 0)
#define MFMA32(a, b, c) __builtin_amdgcn_mfma_f32_32x32x16_bf16((a), (b), (c), 0, 0, 0)

__device__ __forceinline__ void p0_transpose_item(const float* srcp, int ldw, const float* kscale, int K, bf16* WTrow0, LAS unsigned char* scr, int k0, int lane) {
    constexpr int RS = 144;
    const int kr = lane >> 4, n4 = (lane & 15) * 4;
    f32x4 v[16];
#pragma unroll
    for (int i = 0; i < 16; ++i) { v[i] = (f32x4){0.f, 0.f, 0.f, 0.f}; if (srcp) v[i] = *(const f32x4*)(srcp + (size_t)(k0 + 4 * i + kr) * ldw); }
    if (kscale) {
#pragma unroll
        for (int i = 0; i < 16; ++i) v[i] = v[i] * kscale[k0 + 4 * i + kr];
    }
#pragma unroll
    for (int i = 0; i < 16; ++i) { v2u w; w.x = cvtpk(v[i][0], v[i][1]); w.y = cvtpk(v[i][2], v[i][3]); *(LAS v2u*)(scr + (4 * i + kr) * RS + n4 * 2) = w; }
    const int G = lane >> 4, i16 = lane & 15, q = i16 >> 2, p = i16 & 3;
#pragma unroll
    for (int ng = 0; ng < 4; ++ng)
#pragma unroll
        for (int u = 0; u < 2; ++u) { const LAS unsigned char* rp = scr + (8 * (G + 4 * u) + q) * RS + (16 * ng + 4 * p) * 2;
            const bf16x8_t t = cat8(tr_read(rp), tr_read(rp + 4 * RS));
            *(GAS bf16x8_t*)(WTrow0 + (size_t)(16 * ng + i16) * K + k0 + 8 * (G + 4 * u)) = t; }
    LDS_WAIT(); asm volatile("" ::: "memory");
}
__device__ __forceinline__ void p0_prologue(Frame& F) {
    LAS unsigned char* scr = F.lds + F.wave * 16384;
    const int gw = F.vcu * NWAVES + F.wave, NGW = F.G * NWAVES;
    constexpr int I_IN = (D / 64) * (NP1 / 64), I_OUT = (D / 64) * (D / 64), I_GU = (D / 64) * (2 * FF / 64), I_DN = (FF / 64) * (D / 64);
    constexpr int NITEMS = I_IN + I_OUT + I_GU + I_DN;
    const int n4 = (F.lane & 15) * 4;
    for (int it = gw; it < NITEMS; it += NGW) {
        int r = it;
        if (r < I_IN) { const int nblk = NP1 / 64, kb = r / nblk, nb = r % nblk, n = nb * 64 + n4;
            const int sc = n < SRC_GLR ? n : (n < PW ? n + GRANK : (n < PW + GRANK ? SRC_GLR + (n - PW) : -1));
            p0_transpose_item(sc >= 0 ? F.w_in + sc : nullptr, DIN, F.norm1_w, D, F.Win_t + (size_t)(nb * 64) * D, scr, kb * 64, F.lane); continue; }
        r -= I_IN;
        if (r < I_OUT) { const int nblk = D / 64, kb = r / nblk, nb = r % nblk;
            p0_transpose_item(F.w_out + nb * 64 + n4, D, nullptr, D, F.Wout_t + (size_t)(nb * 64) * D, scr, kb * 64, F.lane); continue; }
        r -= I_OUT;
        if (r < I_GU) { const int nblk = 2 * FF / 64, kb = r / nblk, nb = r % nblk, n0 = nb * 64, pn = n0 >> 8, wc = (n0 >> 6) & 3, bj = n4 >> 5, hl = 32 * wc + (n4 & 31);
            p0_transpose_item((bj ? F.w_up : F.w_gate) + pn * 128 + hl, FF, F.norm2_w, D, F.Wgu_t + (size_t)n0 * D, scr, kb * 64, F.lane); continue; }
        r -= I_GU;
        { const int nblk = D / 64, kb = r / nblk, nb = r % nblk;
            p0_transpose_item(F.w_down + nb * 64 + n4, D, nullptr, FF, F.Wdown_t + (size_t)(nb * 64) * FF, scr, kb * 64, F.lane); }
    }
    for (int m = gw; m < M; m += NGW) {
        const GAS f32x4* xr = (const GAS f32x4*)(F.x + (size_t)m * D) + F.lane;
        f32x4 v[8]; float s = 0.f;
#pragma unroll
        for (int j = 0; j < 8; ++j) { v[j] = xr[64 * j]; s += (v[j].x * v[j].x + v[j].y * v[j].y) + (v[j].z * v[j].z + v[j].w * v[j].w); }
        s = wave_sum(s);
        if (F.lane == 0) F.RSTD1[m] = 1.0f / sqrtf(s * (1.0f / D) + RMS_EPS);
        GAS v2u* o8 = (GAS v2u*)(F.XB + (size_t)m * D) + F.lane;
#pragma unroll
        for (int j = 0; j < 8; ++j) { v2u w; w.x = cvtpk(v[j].x, v[j].y); w.y = cvtpk(v[j].z, v[j].w); o8[64 * j] = w; }
    }
}

__device__ __forceinline__ void p2_gla_naive(Frame& F) {
    float* al = (float*)(F.lds);
    float* kk = al + 256;
    float* qq = kk + 256;
    float* vv = qq + 256;
    float* red = vv + 64;
    const int tid = F.tid, lane = F.lane, wave = F.wave;
    const int vl = tid >> 3, dq = tid & 7;
    for (int unit = blockIdx.x; unit < BATCH * GH * 8; unit += gridDim.x) {
        const int b = unit >> 5, h = (unit >> 3) & 3, vs = unit & 7;
        float S[32];
#pragma unroll
        for (int d = 0; d < 32; ++d) S[d] = 0.f;
        float w2r[16]; float bias = 0.f;
        const int dch = tid & 255;
#pragma unroll
        for (int r = 0; r < 16; ++r) w2r[r] = F.gate_w2[r * (GH * GDK) + h * GDK + dch];
        bias = F.gate_b[h * GDK + dch];
        for (int t = 0; t < SEQ; ++t) {
            const size_t row = (size_t)b * SEQ + t;
            const bf16* prow = F.PROJ + row * PW;
            if (tid < 256) {
                const f32x4* g4 = (const f32x4*)(F.GLR + row * 16);
                float logit = bias;
#pragma unroll
                for (int r4 = 0; r4 < 4; ++r4) { const f32x4 g = g4[r4]; logit += g[0] * w2r[4 * r4] + g[1] * w2r[4 * r4 + 1] + g[2] * w2r[4 * r4 + 2] + g[3] * w2r[4 * r4 + 3]; }
                const float ls = fminf(logit, 0.f) - log1pf(expf(-fabsf(logit)));
                al[tid] = expf(ls * (1.0f / 16.0f));
                qq[tid] = bf2f(prow[C_GQ + h * GDK + tid]) * (1.0f / 16.0f);
                kk[tid] = bf2f(prow[C_GK + h * GDK + tid]);
            } else if (tid < 320) {
                vv[tid - 256] = bf2f(prow[C_GV + h * GDV + vs * 64 + (tid - 256)]);
            }
            __syncthreads();
            const float v = vv[vl]; float acc = 0.f;
#pragma unroll
            for (int d = 0; d < 32; ++d) { const int dd = dq * 32 + d; S[d] = al[dd] * S[d] + kk[dd] * v; acc += qq[dd] * S[d]; }
            acc += __shfl_xor(acc, 1); acc += __shfl_xor(acc, 2); acc += __shfl_xor(acc, 4);
            const float ob = bf2f((unsigned short)f2bf(acc));
            float o2 = ob * ob;
            o2 += __shfl_xor(o2, 8); o2 += __shfl_xor(o2, 16); o2 += __shfl_xor(o2, 32);
            if (lane == 0) red[wave] = o2;
            if (dq == 0) ((bf16*)prow)[C_GV + h * GDV + vs * 64 + vl] = (bf16)f2bf(acc);
            __syncthreads();
            if (tid == 0) { float s = 0.f;
#pragma unroll
                for (int w = 0; w < 8; ++w) s += red[w];
                F.SSQG[row * 32 + h * 8 + vs] = s; }
        }
        __syncthreads();
    }
}

__device__ __forceinline__ void p3_attn_naive(Frame& F) {
    constexpr int KST = 66;
    bf16* Ks = (bf16*)F.lds;
    bf16* Vs = Ks + 256 * KST;
    const int tid = F.tid;
    for (int unit = blockIdx.x; unit < BATCH * 16 * NKVH; unit += gridDim.x) {
        const int b = unit >> 6, nb = (unit >> 2) & 15, kvh = unit & 3;
        __syncthreads();
        for (int c = tid; c < 256 * 32; c += NTHREADS) {
            const int j = c >> 5, w = c & 31; const int tok = (nb - 1) * WIN + j;
            unsigned kw = 0u, vw = 0u;
            if (tok >= 0) { const bf16* prow = F.PROJ + ((size_t)b * SEQ + tok) * PW;
                kw = *(const unsigned*)(prow + C_AK + kvh * HD + 2 * w); vw = *(const unsigned*)(prow + C_AV + kvh * HD + 2 * w); }
            *(unsigned*)(Ks + j * KST + 2 * w) = kw; *(unsigned*)(Vs + j * KST + 2 * w) = vw;
        }
        __syncthreads();
        const int g = tid >> 6, hq = kvh * GQA + g;
        const float sink = F.sinks[hq];
        for (int rep = 0; rep < 2; ++rep) {
            const int i = (tid & 63) + 64 * rep;
            const size_t row = (size_t)b * SEQ + nb * WIN + i;
            const bf16* prow = F.PROJ + row * PW;
            float q[64], o[64];
#pragma unroll
            for (int d2 = 0; d2 < 32; ++d2) { const unsigned w = *(const unsigned*)(prow + C_AQ + hq * HD + 2 * d2); q[2 * d2] = bflo(w) * 0.125f; q[2 * d2 + 1] = bfhi(w) * 0.125f; o[2 * d2] = 0.f; o[2 * d2 + 1] = 0.f; }
            float mx = sink, l = 1.0f;
            for (int jj = 1; jj <= WIN; ++jj) {
                const int ki = i + jj;
                if (nb == 0 && ki < WIN) continue;
                const unsigned* kr = (const unsigned*)(Ks + ki * KST);
                float s = 0.f;
#pragma unroll
                for (int d2 = 0; d2 < 32; ++d2) { const unsigned w = kr[d2]; s += q[2 * d2] * bflo(w) + q[2 * d2 + 1] * bfhi(w); }
                const float mn = fmaxf(mx, s), sc = __expf(mx - mn), p = __expf(s - mn);
                l = l * sc + p; mx = mn;
                const unsigned* vr = (const unsigned*)(Vs + ki * KST);
#pragma unroll
                for (int d2 = 0; d2 < 32; ++d2) { const unsigned w = vr[d2]; o[2 * d2] = o[2 * d2] * sc + p * bflo(w); o[2 * d2 + 1] = o[2 * d2 + 1] * sc + p * bfhi(w); }
            }
            const float il = 1.0f / l;
            float sg = 0.f;
#pragma unroll
            for (int s8 = 0; s8 < 8; ++s8) sg += F.SSQG[row * 32 + kvh * 8 + s8];
            const float rg = 1.0f / sqrtf(sg * (1.0f / GDV) + RMS_EPS);
            const int cb = hq * HD;
            bf16* mrow = F.MERGED + row * D + cb;
#pragma unroll
            for (int d2 = 0; d2 < 32; ++d2) {
                const unsigned wa = *(const unsigned*)(prow + C_GA + cb + 2 * d2), wb = *(const unsigned*)(prow + C_GB + cb + 2 * d2);
                const unsigned wr_ = *(const unsigned*)(prow + C_GR + cb + 2 * d2), wg = *(const unsigned*)(prow + C_GV + cb + 2 * d2);
                const float gr0 = bflo(wr_), gr1 = bfhi(wr_);
                const float gl0 = bflo(wg) * rg * F.gnorm_w[g * HD + 2 * d2] * (gr0 * sigmoidf_(gr0));
                const float gl1 = bfhi(wg) * rg * F.gnorm_w[g * HD + 2 * d2 + 1] * (gr1 * sigmoidf_(gr1));
                const float m0 = sigmoidf_(bflo(wa)) * (o[2 * d2] * il) + sigmoidf_(bflo(wb)) * gl0;
                const float m1 = sigmoidf_(bfhi(wa)) * (o[2 * d2 + 1] * il) + sigmoidf_(bfhi(wb)) * gl1;
                *(unsigned*)(mrow + 2 * d2) = pk2(m0, m1);
            }
        }
    }
    __syncthreads();
}

__device__ __forceinline__ void p2a_gla_prep(Frame& F) {
    LAS float* glr_s = (LAS float*)F.lds;
    LAS float* tot = glr_s + 64 * 16;
    const int tid = F.tid, cp = tid & 127, tg = tid >> 7, d0 = 2 * cp;
    for (int unit = F.vcu; unit < BATCH * 32 * GH; unit += F.G) {
        const int b = unit >> 7, c = (unit >> 2) & 31, h = unit & 3;
        const size_t row0 = (size_t)b * SEQ + c * GCHUNK;
        __syncthreads();
        if (tid < 256) ((LAS f32x4*)glr_s)[tid] = ((const f32x4*)(F.GLR + row0 * 16))[tid];
        float wa[16], wb[16];
#pragma unroll
        for (int r = 0; r < 16; ++r) { const float2 w = *(const float2*)(F.gate_w2 + r * (GH * GDK) + h * GDK + d0); wa[r] = w.x; wb[r] = w.y; }
        const float2 bb = *(const float2*)(F.gate_b + h * GDK + d0);
        __syncthreads();
        float ga[16], gb[16]; float ca = 0.f, cb = 0.f;
#pragma unroll
        for (int i = 0; i < 16; ++i) {
            const LAS f32x4* g4 = (const LAS f32x4*)(glr_s + (16 * tg + i) * 16);
            float la = bb.x, lb = bb.y;
#pragma unroll
            for (int r4 = 0; r4 < 4; ++r4) { const f32x4 g = g4[r4];
                la += g[0] * wa[4 * r4] + g[1] * wa[4 * r4 + 1] + g[2] * wa[4 * r4 + 2] + g[3] * wa[4 * r4 + 3];
                lb += g[0] * wb[4 * r4] + g[1] * wb[4 * r4 + 1] + g[2] * wb[4 * r4 + 2] + g[3] * wb[4 * r4 + 3]; }
            const float sa = fminf(la, 0.f) - log1pf(__expf(-fabsf(la))), sb = fminf(lb, 0.f) - log1pf(__expf(-fabsf(lb)));
            ca += sa * (1.0f / 16.0f); cb += sb * (1.0f / 16.0f); ga[i] = ca; gb[i] = cb;
        }
        tot[tg * 256 + d0] = ca; tot[tg * 256 + d0 + 1] = cb;
        __syncthreads();
        float pa = 0.f, pb = 0.f;
#pragma unroll
        for (int t = 0; t < 3; ++t) if (t < tg) { pa += tot[t * 256 + d0]; pb += tot[t * 256 + d0 + 1]; }
        bf16* base = F.PROJ + (row0 + 16 * tg) * PW + h * GDK + d0;
#pragma unroll
        for (int i = 0; i < 16; ++i) {
            const float ea = __expf(pa + ga[i]), eb = __expf(pb + gb[i]);
            unsigned* qp = (unsigned*)(base + (size_t)i * PW + C_GQ); unsigned* kp = (unsigned*)(base + (size_t)i * PW + C_GK);
            const unsigned qw = *qp, kw = *kp;
            *qp = cvtpk(bflo(qw) * ea * (1.0f / 16.0f), bfhi(qw) * eb * (1.0f / 16.0f));
            *kp = cvtpk(bflo(kw) / ea, bfhi(kw) / eb);
        }
        if (tg == 3) { float2 dv; dv.x = __expf(pa + ca); dv.y = __expf(pb + cb); *(float2*)(F.DEC + (size_t)(b * 32 + c) * (GH * GDK) + h * GDK + d0) = dv; }
    }
    __syncthreads();
}

__device__ __forceinline__ void p2b_gla_main(Frame& F) {
    constexpr int QST = 528, VST = 144, AST = 144, OST = 272;
    constexpr int L_QD = 0, L_KI = 64 * QST, L_V = 2 * 64 * QST, L_ATT = L_V + 64 * VST, L_OP = L_ATT + 64 * AST, L_DEC = L_OP + 2 * 64 * OST, L_END = L_DEC + 1024;
    static_assert(L_END <= RING_BYTES, "gla lds");
    LAS unsigned char* lds = F.lds;
    const int tid = F.tid, lane = F.lane, w = F.wave, cw = w & 3, kh = w >> 2, c16 = lane & 15, g = lane >> 4, q4 = (lane & 15) >> 2, p4 = lane & 3;
    for (int i = tid; i < 64 * AST / 4; i += NTHREADS) ((LAS unsigned*)(lds + L_ATT))[i] = 0u;
    for (int unit = F.vcu; unit < BATCH * GH * 8; unit += F.G) {
        const int b = unit >> 5, h = (unit >> 3) & 3, vs = unit & 7;
        f32x4 S[8];
#pragma unroll
        for (int t = 0; t < 8; ++t) S[t] = (f32x4){0.f, 0.f, 0.f, 0.f};
        v4u pq[4], pk[4], pv; float pdec = 0.f;
        const bf16* gq0 = F.PROJ + (size_t)b * SEQ * PW + C_GQ + h * GDK;
        const bf16* gk0 = F.PROJ + (size_t)b * SEQ * PW + C_GK + h * GDK;
        const bf16* gv0 = F.PROJ + (size_t)b * SEQ * PW + C_GV + h * GDV + vs * 64;
        const int gpitch = (h < 3) ? 1536 : 512;
        bf16* go0 = ((h < 3) ? F.G012 + h * GDV : F.G3) + (size_t)b * SEQ * gpitch + vs * 64;
        const float* dec0 = F.DEC + (size_t)b * 32 * (GH * GDK) + h * GDK;
#define GLA_LOAD(c) do { const size_t r0_ = (size_t)(c) * GCHUNK; \
        _Pragma("unroll") for (int i_ = 0; i_ < 4; ++i_) { const int id_ = tid + NTHREADS * i_, row_ = id_ >> 5, ch_ = id_ & 31; \
            pq[i_] = *(const v4u*)(gq0 + (r0_ + row_) * PW + ch_ * 8); pk[i_] = *(const v4u*)(gk0 + (r0_ + row_) * PW + ch_ * 8); } \
        pv = *(const v4u*)(gv0 + (r0_ + (tid >> 3)) * PW + (tid & 7) * 8); \
        if (tid < 256) pdec = dec0[(size_t)(c) * (GH * GDK) + tid]; } while (0)
#define GLA_STORE() do { \
        _Pragma("unroll") for (int i_ = 0; i_ < 4; ++i_) { const int id_ = tid + NTHREADS * i_, row_ = id_ >> 5, ch_ = id_ & 31; \
            *(LAS v4u*)(lds + L_QD + row_ * QST + ch_ * 16) = pq[i_]; *(LAS v4u*)(lds + L_KI + row_ * QST + ch_ * 16) = pk[i_]; } \
        *(LAS v4u*)(lds + L_V + (tid >> 3) * VST + (tid & 7) * 16) = pv; \
        if (tid < 256) *(LAS float*)(lds + L_DEC + tid * 4) = pdec; } while (0)
        __syncthreads();
        GLA_LOAD(0); GLA_STORE();
        __syncthreads();
        for (int c = 0; c < SEQ / GCHUNK; ++c) {
            if (c + 1 < SEQ / GCHUNK) GLA_LOAD(c + 1);
#pragma unroll
            for (int tt = 0; tt < 2; ++tt) { const int tile = 2 * w + tt, it = tile >> 2, jt = tile & 3;
                if (jt <= it) {
                    f32x4 acc = {0.f, 0.f, 0.f, 0.f};
                    const LAS unsigned char* ap = lds + L_QD + (16 * it + c16) * QST + g * 16; const LAS unsigned char* bp = lds + L_KI + (16 * jt + c16) * QST + g * 16;
#pragma unroll
                    for (int s = 0; s < 8; ++s) { const bf16x8_t a = *(const LAS bf16x8_t*)(ap + s * 64), bb = *(const LAS bf16x8_t*)(bp + s * 64); acc = MFMA16(a, bb, acc); }
#pragma unroll
                    for (int r = 0; r < 4; ++r) { float v = acc[r]; if (it == jt && c16 > 4 * g + r) v = 0.f;
                        *(LAS unsigned short*)(lds + L_ATT + (16 * it + 4 * g + r) * AST + (16 * jt + c16) * 2) = (unsigned short)f2bf(v); }
                }
            }
            __syncthreads();
            bf16x8_t vf[2];
#pragma unroll
            for (int s = 0; s < 2; ++s) { const LAS unsigned char* vp = lds + L_V + (32 * s + 8 * g + q4) * VST + (16 * cw + 4 * p4) * 2; vf[s] = cat8(tr_read(vp), tr_read(vp + 4 * VST)); }
            bf16x8_t sb[4];
#pragma unroll
            for (int s = 0; s < 4; ++s) { v4u t; t.x = cvtpk(S[2 * s][0], S[2 * s][1]); t.y = cvtpk(S[2 * s][2], S[2 * s][3]); t.z = cvtpk(S[2 * s + 1][0], S[2 * s + 1][1]); t.w = cvtpk(S[2 * s + 1][2], S[2 * s + 1][3]); sb[s] = __builtin_bit_cast(bf16x8_t, t); }
#pragma unroll
            for (int it = 0; it < 4; ++it) {
                f32x4 oa = {0.f, 0.f, 0.f, 0.f};
                { const bf16x8_t a = *(const LAS bf16x8_t*)(lds + L_ATT + (16 * it + c16) * AST + (32 * kh + 8 * g) * 2); oa = MFMA16(a, kh ? vf[1] : vf[0], oa); }
                const LAS unsigned char* qp = lds + L_QD + (16 * it + c16) * QST + (128 * kh + 4 * g) * 2;
#pragma unroll
                for (int s = 0; s < 4; ++s) { const s16x4_t lo = *(const LAS s16x4_t*)(qp + s * 64), hi = *(const LAS s16x4_t*)(qp + s * 64 + 32); oa = MFMA16(cat8(lo, hi), sb[s], oa); }
#pragma unroll
                for (int r = 0; r < 4; ++r) *(LAS float*)(lds + L_OP + kh * 64 * OST + (16 * it + 4 * g + r) * OST + (16 * cw + c16) * 4) = oa[r];
            }
#pragma unroll
            for (int t = 0; t < 8; ++t) {
#pragma unroll
                for (int s = 0; s < 2; ++s) { const LAS unsigned char* kp = lds + L_KI + (32 * s + 8 * g + q4) * QST + (128 * kh + 16 * t + 4 * p4) * 2; S[t] = MFMA16(cat8(tr_read(kp), tr_read(kp + 4 * QST)), vf[s], S[t]); }
                const f32x4 dc = *(const LAS f32x4*)(lds + L_DEC + (128 * kh + 16 * t + 4 * g) * 4);
                S[t] = S[t] * dc;
            }
            __syncthreads();
            { const int row = tid >> 3, cg = tid & 7;
                const LAS f32x4* o0 = (const LAS f32x4*)(lds + L_OP + row * OST + cg * 32); const LAS f32x4* o1 = (const LAS f32x4*)(lds + L_OP + 64 * OST + row * OST + cg * 32);
                const f32x4 a = o0[0] + o1[0], bq = o0[1] + o1[1];
                v4u wv; wv.x = cvtpk(a[0], a[1]); wv.y = cvtpk(a[2], a[3]); wv.z = cvtpk(bq[0], bq[1]); wv.w = cvtpk(bq[2], bq[3]);
                const size_t grow = (size_t)c * GCHUNK + row;
                *(v4u*)(go0 + grow * gpitch + cg * 8) = wv;
                float ss = (a[0] * a[0] + a[1] * a[1]) + (a[2] * a[2] + a[3] * a[3]) + (bq[0] * bq[0] + bq[1] * bq[1]) + (bq[2] * bq[2] + bq[3] * bq[3]);
                ss += __shfl_xor(ss, 1); ss += __shfl_xor(ss, 2); ss += __shfl_xor(ss, 4);
                if (cg == 0) F.SSQG[((size_t)b * SEQ + grow) * 32 + h * 8 + vs] = ss; }
            if (c + 1 < SEQ / GCHUNK) GLA_STORE();
            __syncthreads();
        }
#undef GLA_LOAD
#undef GLA_STORE
    }
}

__device__ __forceinline__ int crow(int r, int hi) { return (r & 3) + 8 * (r >> 2) + 4 * hi; }
__device__ __forceinline__ void p3_attn(Frame& F) {
    constexpr int KST = 144, VST = 192;
    constexpr int L_K = 0, L_V = 256 * KST, L_OST = L_V + 256 * VST, L_WSF = L_OST + 8 * 4096, L_END = L_WSF + 8 * 128;
    static_assert(L_END <= RING_BYTES, "attn lds");
    LAS unsigned char* lds = F.lds;
    const int tid = F.tid, lane = F.lane, w = F.wave, r32 = lane & 31, hi = lane >> 5, q4 = (lane & 15) >> 2, p4 = lane & 3, blk = (lane >> 4) & 1;
    constexpr float C2 = 0.125f * 1.4426950408889634f, LOG2E = 1.4426950408889634f, NEG = -1e30f;
    LAS unsigned char* ost = lds + L_OST + w * 4096;
    LAS float* wsf = (LAS float*)(lds + L_WSF + w * 128);
    for (int unit = F.vcu; unit < BATCH * 16 * NKVH; unit += F.G) {
        const int b = unit >> 6, nb = (unit >> 2) & 15, kvh = unit & 3;
        __syncthreads();
#pragma unroll
        for (int i = 0; i < 4; ++i) { const int id = tid + NTHREADS * i, row = id >> 3, ch = id & 7; const int tok = (nb - 1) * WIN + row;
            v4u kv = {0u, 0u, 0u, 0u}, vv = {0u, 0u, 0u, 0u};
            if (tok >= 0) { const bf16* prow = F.PROJ + ((size_t)b * SEQ + tok) * PW + kvh * HD + ch * 8; kv = *(const v4u*)(prow + C_AK); vv = *(const v4u*)(prow + C_AV); }
            *(LAS v4u*)(lds + L_K + row * KST + ch * 16) = kv; *(LAS v4u*)(lds + L_V + row * VST + ch * 16) = vv; }
        __syncthreads();
        const int hq = kvh * GQA + w;
        const int gpitch = (kvh < 3) ? 1536 : 512; const bf16* gsrc = ((kvh < 3) ? F.G012 + kvh * GDV : F.G3) + w * HD;
        const float sink2 = F.sinks[hq] * LOG2E;
        float gw8[8];
        { const f32x4 g0 = *(const f32x4*)(F.gnorm_w + w * HD + (lane & 7) * 8), g1 = *(const f32x4*)(F.gnorm_w + w * HD + (lane & 7) * 8 + 4);
            gw8[0] = g0[0]; gw8[1] = g0[1]; gw8[2] = g0[2]; gw8[3] = g0[3]; gw8[4] = g1[0]; gw8[5] = g1[1]; gw8[6] = g1[2]; gw8[7] = g1[3]; }
        for (int qt = 0; qt < 4; ++qt) {
            const size_t rowq = (size_t)b * SEQ + nb * WIN + 32 * qt;
            bf16x8_t qf[4];
#pragma unroll
            for (int s = 0; s < 4; ++s) qf[s] = *(const bf16x8_t*)(F.PROJ + (rowq + r32) * PW + C_AQ + hq * HD + 16 * s + 8 * hi);
            const int kt_lo = (nb == 0 && qt < 4) ? 4 - qt : 0;
            f32x16 sc[5];
#pragma unroll
            for (int k5 = 0; k5 < 5; ++k5) {
#pragma unroll
                for (int r = 0; r < 16; ++r) sc[k5][r] = NEG;
                if (k5 >= kt_lo) {
                    f32x16 acc;
#pragma unroll
                    for (int r = 0; r < 16; ++r) acc[r] = 0.f;
                    const LAS unsigned char* kp = lds + L_K + (32 * (qt + k5) + r32) * KST + hi * 16;
#pragma unroll
                    for (int s = 0; s < 4; ++s) acc = MFMA32(*(const LAS bf16x8_t*)(kp + s * 32), qf[s], acc);
#pragma unroll
                    for (int r = 0; r < 16; ++r) { const int kvl = crow(r, hi); bool ok = true; if (k5 == 0) ok = kvl > r32; if (k5 == 4) ok = kvl <= r32; sc[k5][r] = ok ? acc[r] * C2 : NEG; }
                }
            }
            float mx = sink2;
#pragma unroll
            for (int k5 = 0; k5 < 5; ++k5)
#pragma unroll
                for (int r = 0; r < 16; ++r) mx = fmaxf(mx, sc[k5][r]);
            mx = fmaxf(mx, __shfl_xor(mx, 32));
            float lsum = 0.f;
            f32x16 o[2];
#pragma unroll
            for (int r = 0; r < 16; ++r) { o[0][r] = 0.f; o[1][r] = 0.f; }
#pragma unroll
            for (int k5 = 0; k5 < 5; ++k5) {
                if (k5 >= kt_lo) {
                    float p[16];
#pragma unroll
                    for (int r = 0; r < 16; ++r) { p[r] = __builtin_amdgcn_exp2f(sc[k5][r] - mx); lsum += p[r]; }
#pragma unroll
                    for (int s2 = 0; s2 < 2; ++s2) {
                        v4u t; t.x = cvtpk(p[8 * s2], p[8 * s2 + 1]); t.y = cvtpk(p[8 * s2 + 2], p[8 * s2 + 3]); t.z = cvtpk(p[8 * s2 + 4], p[8 * s2 + 5]); t.w = cvtpk(p[8 * s2 + 6], p[8 * s2 + 7]);
                        const bf16x8_t pa = __builtin_bit_cast(bf16x8_t, t);
                        const LAS unsigned char* vp = lds + L_V + (32 * (qt + k5) + 16 * s2 + 4 * hi + q4) * VST + (16 * blk + 4 * p4) * 2;
#pragma unroll
                        for (int d0 = 0; d0 < 2; ++d0) { const bf16x8_t vb = cat8(tr_read(vp + d0 * 64), tr_read(vp + d0 * 64 + 8 * VST)); o[d0] = MFMA32(pa, vb, o[d0]); }
                    }
                }
            }
            lsum += __shfl_xor(lsum, 32);
            lsum += __builtin_amdgcn_exp2f(sink2 - mx);
            if (hi == 0) wsf[r32] = 1.0f / lsum;
#pragma unroll
            for (int r = 0; r < 16; ++r) { const int qr = crow(r, hi); const float rl = wsf[qr];
                *(LAS unsigned short*)(ost + qr * 128 + r32 * 2) = (unsigned short)f2bf(o[0][r] * rl);
                *(LAS unsigned short*)(ost + qr * 128 + (32 + r32) * 2) = (unsigned short)f2bf(o[1][r] * rl); }
#pragma unroll
            for (int i = 0; i < 4; ++i) { const int id = lane + 64 * i, row = id >> 3, ch = id & 7;
                const v4u av = *(const LAS v4u*)(ost + row * 128 + ch * 16);
                const size_t tok = rowq + row; const int cb = hq * HD + ch * 8;
                const bf16* prow = F.PROJ + tok * PW + cb;
                const v4u ga = *(const v4u*)(prow + C_GA), gb = *(const v4u*)(prow + C_GB), gr = *(const v4u*)(prow + C_GR), gg = *(const v4u*)(gsrc + tok * gpitch + ch * 8);
                const f32x4 s0 = *(const f32x4*)(F.SSQG + tok * 32 + kvh * 8), s1 = *(const f32x4*)(F.SSQG + tok * 32 + kvh * 8 + 4);
                const float rg = 1.0f / sqrtf(((s0[0] + s0[1]) + (s0[2] + s0[3]) + (s1[0] + s1[1]) + (s1[2] + s1[3])) * (1.0f / GDV) + RMS_EPS);
                float res[8];
#pragma unroll
                for (int j = 0; j < 4; ++j) {
                    const float a0 = bflo(av[j]), a1 = bfhi(av[j]), x0 = bflo(gr[j]), x1 = bfhi(gr[j]);
                    const float l0 = bflo(gg[j]) * rg * gw8[2 * j] * (x0 * sigmoidf_(x0)), l1 = bfhi(gg[j]) * rg * gw8[2 * j + 1] * (x1 * sigmoidf_(x1));
                    res[2 * j] = sigmoidf_(bflo(ga[j])) * a0 + sigmoidf_(bflo(gb[j])) * l0;
                    res[2 * j + 1] = sigmoidf_(bfhi(ga[j])) * a1 + sigmoidf_(bfhi(gb[j])) * l1;
                }
                v4u ov; ov.x = cvtpk(res[0], res[1]); ov.y = cvtpk(res[2], res[3]); ov.z = cvtpk(res[4], res[5]); ov.w = cvtpk(res[6], res[7]);
                *(v4u*)(F.MERGED + tok * D + cb) = ov; }
        }
    }
    __syncthreads();
}

__device__ __forceinline__ void p7_final_norm(Frame& F) {
    const int gw = F.vcu * NWAVES + F.wave, NGW = F.G * NWAVES;
    f32x4 wv[8];
#pragma unroll
    for (int j = 0; j < 8; ++j) wv[j] = ((const f32x4*)F.fnorm_w)[F.lane + 64 * j];
    for (int m = gw; m < M; m += NGW) {
        float s = (F.lane < 32) ? F.SSQ3[(size_t)m * 32 + F.lane] : 0.f;
        s = wave_sum(s);
        const float rs = 1.0f / sqrtf(s * (1.0f / D) + RMS_EPS);
        GAS f32x4* xr = (GAS f32x4*)(F.out + (size_t)m * D) + F.lane;
#pragma unroll
        for (int j = 0; j < 8; ++j) { f32x4 v = xr[64 * j]; v = v * rs * wv[j]; xr[64 * j] = v; }
    }
}

struct Args { const float* in[13]; float* out; unsigned char* ws; int ph_lo, ph_hi; };
__global__ void __launch_bounds__(NTHREADS, 2) hybrid_fwd(Args args) {
    extern __shared__ __attribute__((aligned(16))) unsigned char lds[];
    Frame F;
    F.lds = (LAS unsigned char*)lds;
    F.MISC = (volatile LAS unsigned*)(F.lds + MISC_OFF);
    F.tid = threadIdx.x; F.lane = F.tid & 63; F.wave = __builtin_amdgcn_readfirstlane(F.tid >> 6);
    F.G = gridDim.x; { const int bx = blockIdx.x; F.vcu = (F.G % 8 == 0) ? (bx % 8) * (F.G / 8) + bx / 8 : bx; }
    unsigned char* ws = args.ws;
    F.ws = ws; F.ctl = (gu32*)(ws + WS_CTL);
    F.x = args.in[0]; F.norm1_w = args.in[1]; F.w_in = args.in[2]; F.gate_w2 = args.in[3]; F.gate_b = args.in[4]; F.sinks = args.in[5]; F.gnorm_w = args.in[6];
    F.w_out = args.in[7]; F.norm2_w = args.in[8]; F.w_gate = args.in[9]; F.w_up = args.in[10]; F.w_down = args.in[11]; F.fnorm_w = args.in[12];
    F.out = args.out;
    F.Win_t = (bf16*)(ws + WS_WIN); F.Wout_t = (bf16*)(ws + WS_WOUT); F.Wdown_t = (bf16*)(ws + WS_WDOWN); F.Wgu_t = (bf16*)((unsigned char*)args.out + OUT_WGU);
    F.XB = (bf16*)((unsigned char*)args.out + OUT_XB); F.MERGED = F.XB; F.PROJ = (bf16*)(ws + WS_PROJ); F.H1B = (bf16*)(ws + WS_H1B); F.FFB = (bf16*)(ws + WS_FF);
    F.RSTD1 = (float*)(ws + WS_RSTD1); F.GLR = (float*)(ws + WS_GLR); F.DEC = (float*)(ws + WS_DEC); F.SSQG = (float*)(ws + WS_SSQG); F.SSQ2 = (float*)(ws + WS_SSQ2); F.SSQ3 = (float*)(ws + WS_SSQ3);
    F.H1 = (float*)(ws + WS_H1);
    F.G012 = (bf16*)(ws + WS_WIN); F.G3 = (bf16*)((unsigned char*)args.out + OUT_G3);
    for (int u = F.tid; u < (LDS_BYTES - LDSCTL_OFF) / 4; u += NTHREADS) ((LAS unsigned*)(F.lds + LDSCTL_OFF))[u] = 0u;
    __syncthreads();
    XcdBarrier bar; bar.bar = (unsigned*)(F.ctl + CW_BAR); bar.x = 0; bar.st = nullptr;
    if (N_LAUNCHES == 1) bar = xcd_barrier_post((unsigned*)(F.ctl + CW_BAR), F.MISC + 8);
    const int lo = args.ph_lo, hi = args.ph_hi;
#define IN(k) (lo <= (k) && (k) < hi)
#ifndef REPEAT_PHASE
#define REPEAT_PHASE -1
#endif
#define REP(k) for (int rep_ = 0; rep_ < ((k) == REPEAT_PHASE ? 2 : 1); ++rep_)
#define SEAM(k) do { if (IN(k) && IN((k) + 1)) xcd_barrier(bar); } while (0)

    if (IN(0)) { REP(0) p0_prologue(F); SEAM(0); }
    if (IN(1)) {
        {
        pg8::Gemm g{F.XB, F.Win_t, M, NP1, D}; pg8::StaticOrder S; S.init(M, NP1, F.G, (int)blockIdx.x, REPEAT_PHASE == 1 ? 2 : 1);
        pg8::EpiProj E{F.PROJ, PW, F.RSTD1, F.GLR, PW / 256};
        pg8::gemm_phase<pg8::EpiProj, pg8::StaticOrder, true, true>(F.lds, g, S, E);
        }
        SEAM(1);
    }
#if GLA_OPT
    if (IN(2)) { p2a_gla_prep(F); SEAM(2); }
    if (IN(3)) { REP(3) p2b_gla_main(F); SEAM(3); }
#else
    if (IN(2)) { SEAM(2); }
    if (IN(3)) { p2_gla_naive(F); SEAM(3); }
#endif
#if ATT_OPT
    if (IN(4)) { REP(4) p3_attn(F); SEAM(4); }
#else
    if (IN(4)) { p3_attn_naive(F); SEAM(4); }
#endif
    if (IN(5)) {
        {
        pg8::Gemm g{F.MERGED, F.Wout_t, M, D, D}; pg8::StaticOrder S; S.init(M, D, F.G, (int)blockIdx.x, REPEAT_PHASE == 5 ? 2 : 1);
        pg8::EpiRes1 E{F.x, F.H1B, D, F.SSQ2};
        pg8::gemm_phase<pg8::EpiRes1, pg8::StaticOrder, true, true>(F.lds, g, S, E);
        }
        SEAM(5);
    }
    if (IN(6)) {
        {
        pg8::Gemm g{F.H1B, F.Wgu_t, M, 2 * FF, D}; pg8::StaticOrder S; S.init(M, 2 * FF, F.G, (int)blockIdx.x, REPEAT_PHASE == 6 ? 2 : 1);
        pg8::EpiSwiGLU E{F.FFB, FF, F.SSQ2, 1.0f / D};
        pg8::gemm_phase<pg8::EpiSwiGLU, pg8::StaticOrder, true, true>(F.lds, g, S, E);
        }
        SEAM(6);
    }
    if (IN(7)) {
        {
        pg8::Gemm g{F.FFB, F.Wdown_t, M, D, FF}; pg8::StaticOrder S; S.init(M, D, F.G, (int)blockIdx.x, REPEAT_PHASE == 7 ? 2 : 1);
        pg8::EpiRes2 E{F.H1B, F.out, D, F.SSQ3};
        pg8::gemm_phase<pg8::EpiRes2, pg8::StaticOrder, true, true>(F.lds, g, S, E);
        }
        SEAM(7);
    }
    if (IN(8)) { p7_final_norm(F); }
#undef IN
#undef SEAM
}

extern "C" void kernel_launch(void* const* d_in, const int* in_sizes, int n_in, void* d_out, int out_size, void* d_ws, size_t ws_size, hipStream_t stream) {
    static int grid = 0;
    if (grid == 0) {
        if (n_in != 13 || in_sizes[0] != M * D || out_size != M * D || ws_size < WS_END) { fprintf(stderr, "kernel_launch: unexpected shapes (n_in %d, in0 %d, out %d, ws %zu)\n", n_in, n_in > 0 ? in_sizes[0] : -1, out_size, ws_size); grid = -1; return; }
        int dev = 0, cus = 0, per_cu = 0;
        if (hipGetDevice(&dev) != hipSuccess || hipDeviceGetAttribute(&cus, hipDeviceAttributeMultiprocessorCount, dev) != hipSuccess) { grid = -1; return; }
        if (hipFuncSetAttribute((const void*)hybrid_fwd, hipFuncAttributeMaxDynamicSharedMemorySize, LDS_BYTES) != hipSuccess) { fprintf(stderr, "kernel_launch: hipFuncSetAttribute failed\n"); grid = -1; return; }
        if (hipOccupancyMaxActiveBlocksPerMultiprocessor(&per_cu, (const void*)hybrid_fwd, NTHREADS, LDS_BYTES) != hipSuccess || per_cu < 1) { fprintf(stderr, "kernel_launch: occupancy query reports %d\n", per_cu); }
        (void)hipGetLastError();
        grid = cus;
    }
    if (grid < 0) return;
    (void)hipMemsetAsync((char*)d_ws + WS_CTL, 0, CTL_ZERO_BYTES, stream);
    Args a{};
    for (int i = 0; i < 13; ++i) a.in[i] = (const float*)d_in[i];
    a.out = (float*)d_out; a.ws = (unsigned char*)d_ws;
    if (N_LAUNCHES == 1) { a.ph_lo = 0; a.ph_hi = N_PHASES; hipLaunchKernelGGL(hybrid_fwd, dim3(grid), dim3(NTHREADS), LDS_BYTES, stream, a); }
    else for (int li = 0; li < N_PHASES; ++li) { a.ph_lo = li; a.ph_hi = li + 1; hipLaunchKernelGGL(hybrid_fwd, dim3(grid), dim3(NTHREADS), LDS_BYTES, stream, a); }
}
```
